# Optimizing an MI355X kernel written in HIP

```python
import jax, jax.numpy as jnp
from jax import lax
import numpy as np

D_MODEL = 1024
BATCH = 8
SEQ = 4096
DEPTH = 2

N_META = 16
N_MIXERS = 2
RMS_EPS = 1e-6

MLA_HEADS = 8
QK_NOPE = 128
QK_ROPE = 64
V_HEAD = 128
Q_LORA = 384
KV_LORA = 256
MLA_WIDTH = MLA_HEADS * V_HEAD
ROPE_BASE = 10000.0
Q_BLOCK = 128
MASK_VALUE = -1e30

LRU_WIDTH = 1024
LRU_BLOCKS = 4
LRU_BLOCK = LRU_WIDTH // LRU_BLOCKS
CONV_WIDTH = 4
LRU_C = 8.0

kernel_name = 'mla_rglru_interleaved_hybrid'


def rmsnorm(x, g):
    xf = x.astype(jnp.float32)
    y = xf * lax.rsqrt(jnp.mean(xf * xf, axis=-1, keepdims=True) + RMS_EPS)
    return (y * g.astype(jnp.float32)).astype(x.dtype)


def rotate_half_split(x, cos, sin):
    x1, x2 = jnp.split(x, 2, axis=-1)
    return jnp.concatenate([x1 * cos - x2 * sin, x1 * sin + x2 * cos], axis=-1).astype(x.dtype)


def block_causal_attention(q_nope, q_rope, k_nope, k_rope, v):
    B, T, H, _ = q_nope.shape
    pad = (-T) % Q_BLOCK
    Tp = T + pad
    nb = Tp // Q_BLOCK

    def padt(a):
        return jnp.pad(a, [(0, 0), (pad, 0)] + [(0, 0)] * (a.ndim - 2))

    q_nope, q_rope, k_nope, k_rope, v = (padt(a) for a in (q_nope, q_rope, k_nope, k_rope, v))
    scale = (QK_NOPE + QK_ROPE) ** -0.5
    key_idx = jnp.arange(Tp)

    def to_blocks(a):
        return jnp.moveaxis(a.reshape(B, nb, Q_BLOCK, *a.shape[2:]), 1, 0)

    def one_block(args):
        blk, qn, qr = args
        s = (jnp.einsum('bqhd,bkhd->bhqk', qn, k_nope, preferred_element_type=jnp.float32)
             + jnp.einsum('bqhr,bkr->bhqk', qr, k_rope, preferred_element_type=jnp.float32)) * scale
        q_idx = blk * Q_BLOCK + jnp.arange(Q_BLOCK)
        mask = (key_idx[None, :] <= q_idx[:, None]) & (key_idx[None, :] >= pad)
        s = jnp.where(mask[None, None], s, MASK_VALUE)
        p = jax.nn.softmax(s, axis=-1)
        return jnp.einsum('bhqk,bkhd->bqhd', p.astype(v.dtype), v)

    out = lax.map(one_block, (jnp.arange(nb), to_blocks(q_nope), to_blocks(q_rope)))
    out = jnp.moveaxis(out, 0, 1).reshape(B, Tp, H, V_HEAD)
    return out[:, pad:]


def mla_mixer(h, w_in, q_norm_g, kv_norm_g, w_uq, w_ukv, w_out):
    B, T, _ = h.shape
    proj = h @ w_in
    q_lat, kv_lat, k_rope, gate = jnp.split(
        proj, [Q_LORA, Q_LORA + KV_LORA, Q_LORA + KV_LORA + QK_ROPE], axis=-1)
    q = (rmsnorm(q_lat, q_norm_g) @ w_uq).reshape(B, T, MLA_HEADS, QK_NOPE + QK_ROPE)
    q_nope, q_rope = q[..., :QK_NOPE], q[..., QK_NOPE:]
    kv = (rmsnorm(kv_lat, kv_norm_g) @ w_ukv).reshape(B, T, MLA_HEADS, QK_NOPE + V_HEAD)
    k_nope, v = kv[..., :QK_NOPE], kv[..., QK_NOPE:]
    pos = jnp.arange(T, dtype=jnp.float32)
    inv_freq = ROPE_BASE ** (-jnp.arange(0, QK_ROPE, 2, dtype=jnp.float32) / QK_ROPE)
    ang = pos[:, None] * inv_freq[None, :]
    cos, sin = jnp.cos(ang), jnp.sin(ang)
    q_rope = rotate_half_split(q_rope, cos[:, None, :], sin[:, None, :])
    k_rope = rotate_half_split(k_rope, cos, sin)
    attn = block_causal_attention(q_nope, q_rope, k_nope, k_rope, v)
    y = attn.reshape(B, T, MLA_WIDTH) * jax.nn.silu(gate)
    return y @ w_out


def rglru_mixer(h, w_in, conv_w, conv_b, w_rg, b_rg, w_ig, b_ig, lam, w_out):
    B, T, _ = h.shape
    proj = h @ w_in
    u, gate = jnp.split(proj, [LRU_WIDTH], axis=-1)
    up = jnp.pad(u, ((0, 0), (CONV_WIDTH - 1, 0), (0, 0)))
    uc = conv_b + up[:, 0:T] * conv_w[0]
    for j in range(1, CONV_WIDTH):
        uc = uc + up[:, j:j + T] * conv_w[j]
    ub = uc.reshape(B, T, LRU_BLOCKS, LRU_BLOCK)
    r = jax.nn.sigmoid(jnp.einsum('btgi,gij->btgj', ub, w_rg).reshape(B, T, LRU_WIDTH) + b_rg)
    i = jax.nn.sigmoid(jnp.einsum('btgi,gij->btgj', ub, w_ig).reshape(B, T, LRU_WIDTH) + b_ig)
    log_a = -LRU_C * r.astype(jnp.float32) * jax.nn.softplus(-lam.astype(jnp.float32))
    a = jnp.exp(log_a)
    mult = jnp.sqrt(-jnp.expm1(2.0 * log_a))
    mult = jnp.where(jnp.arange(T)[None, :, None] == 0, 1.0, mult)
    b = mult * (i * uc).astype(jnp.float32)

    def combine(left, right):
        a1, b1 = left
        a2, b2 = right
        return a1 * a2, a2 * b1 + b2

    _, hs = lax.associative_scan(combine, (a, b), axis=1)
    y = hs.astype(h.dtype) * jax.nn.silu(gate)
    return y @ w_out


def setup_inputs(seed: int = 0) -> dict:
    key = jax.random.key(seed)
    ks = jax.random.split(key, 24)
    n_a = (DEPTH + 1) // 2
    n_b = DEPTH // 2
    d = D_MODEL
    f32 = jnp.float32

    def nrm(k, shape, fan_in):
        return jax.random.normal(k, shape, f32) * (fan_in ** -0.5)

    def gain(k, shape):
        return 1.0 + 0.01 * jax.random.normal(k, shape, f32)

    a_in_cols = Q_LORA + KV_LORA + QK_ROPE + MLA_WIDTH
    u0 = jax.random.uniform(ks[17], (n_b, LRU_WIDTH), f32, minval=0.9, maxval=0.999)
    s0 = u0 ** (1.0 / LRU_C)
    lam = jnp.log(s0) - jnp.log1p(-s0)
    return {
        'x': jax.random.normal(ks[0], (BATCH, SEQ, d), f32),
        'meta_tokens': jax.random.normal(ks[1], (N_META, d), f32),
        'a_norm_g': gain(ks[2], (n_a, d)),
        'a_w_in': nrm(ks[3], (n_a, d, a_in_cols), d),
        'a_q_norm_g': gain(ks[4], (n_a, Q_LORA)),
        'a_kv_norm_g': gain(ks[5], (n_a, KV_LORA)),
        'a_w_uq': nrm(ks[6], (n_a, Q_LORA, MLA_HEADS * (QK_NOPE + QK_ROPE)), Q_LORA),
        'a_w_ukv': nrm(ks[7], (n_a, KV_LORA, MLA_HEADS * (QK_NOPE + V_HEAD)), KV_LORA),
        'a_w_out': nrm(ks[8], (n_a, MLA_WIDTH, d), MLA_WIDTH),
        'b_norm_g': gain(ks[9], (n_b, d)),
        'b_w_in': nrm(ks[10], (n_b, d, 2 * LRU_WIDTH), d),
        'b_conv_w': nrm(ks[11], (n_b, CONV_WIDTH, LRU_WIDTH), CONV_WIDTH),
        'b_conv_b': 0.01 * jax.random.normal(ks[12], (n_b, LRU_WIDTH), f32),
        'b_w_rg': nrm(ks[13], (n_b, LRU_BLOCKS, LRU_BLOCK, LRU_BLOCK), LRU_BLOCK),
        'b_b_rg': 0.01 * jax.random.normal(ks[14], (n_b, LRU_WIDTH), f32),
        'b_w_ig': nrm(ks[15], (n_b, LRU_BLOCKS, LRU_BLOCK, LRU_BLOCK), LRU_BLOCK),
        'b_b_ig': 0.01 * jax.random.normal(ks[16], (n_b, LRU_WIDTH), f32),
        'b_lam': lam,
        'b_w_out': nrm(ks[18], (n_b, LRU_WIDTH, d), LRU_WIDTH),
        'final_norm_g': gain(ks[19], (d,)),
    }


def reference(x, meta_tokens, a_norm_g, a_w_in, a_q_norm_g, a_kv_norm_g, a_w_uq, a_w_ukv,
              a_w_out, b_norm_g, b_w_in, b_conv_w, b_conv_b, b_w_rg, b_b_rg, b_w_ig, b_b_ig,
              b_lam, b_w_out, final_norm_g):
    B = x.shape[0]
    meta = jnp.broadcast_to(meta_tokens[None].astype(x.dtype), (B, N_META, x.shape[-1]))
    h = jnp.concatenate([meta, x], axis=1)
    for layer in range(DEPTH):
        j = layer // N_MIXERS
        if layer % N_MIXERS == 0:
            h = h + mla_mixer(rmsnorm(h, a_norm_g[j]), a_w_in[j], a_q_norm_g[j], a_kv_norm_g[j],
                              a_w_uq[j], a_w_ukv[j], a_w_out[j])
        else:
            h = h + rglru_mixer(rmsnorm(h, b_norm_g[j]), b_w_in[j], b_conv_w[j], b_conv_b[j],
                                b_w_rg[j], b_b_rg[j], b_w_ig[j], b_b_ig[j], b_lam[j], b_w_out[j])
    h = rmsnorm(h, final_norm_g)
    return h[:, N_META:]
```

```cpp
#include <hip/hip_runtime.h>
#include <hip/hip_cooperative_groups.h>
#include <cstdio>
#include <cstdint>
namespace cg = cooperative_groups;

#ifndef SINGLE_LAUNCH
#define SINGLE_LAUNCH 0
#endif

#define DI __device__ __forceinline__
typedef unsigned short bf16_t;
using bf16x8 = __attribute__((ext_vector_type(8))) short;
using f32x4  = __attribute__((ext_vector_type(4))) float;
using f32x16 = __attribute__((ext_vector_type(16))) float;
using u32x4 = __attribute__((ext_vector_type(4))) unsigned;
typedef __bf16 bf16v2 __attribute__((ext_vector_type(2)));

constexpr int NB = 8, SEQ = 4096, NMETA = 16;
constexpr int TP = 4224;
constexpr int PAD = 112;
constexpr int MP = NB * TP;
constexpr int NMT = MP / 128;
constexpr int DM = 1024;
constexpr int NTB = TP / 128;
constexpr float RMS_EPS = 1e-6f;
constexpr float QSCALE = 0.07216878364870322f * 1.4426950408889634f;

constexpr size_t SZ = (size_t)MP * 1024 * 2;
constexpr size_t OFF_XN0 = 0;
constexpr size_t OFF_Y = 0;
constexpr size_t OFF_U = 0;
constexpr size_t OFF_QLAT = SZ;
constexpr size_t OFF_GATEB = SZ;
constexpr size_t OFF_GATEA = 2 * SZ;
constexpr size_t OFF_H1B = 2 * SZ;
constexpr size_t OFF_HSL = 2 * SZ;
constexpr size_t OFF_Q = 3 * SZ;
constexpr size_t OFF_KN = 4 * SZ + SZ / 2;
constexpr size_t OFF_VT = 5 * SZ + SZ / 2;
constexpr size_t OFF_H1 = 3 * SZ;
constexpr size_t OFF_PCUM = 5 * SZ;
constexpr size_t OFF_MISC = 6 * SZ + SZ / 2;
constexpr size_t OFF_KROPE = OFF_MISC;
constexpr size_t OFF_WINA = OFF_KROPE + (size_t)MP * 64 * 2;
constexpr size_t OFF_WUQ = OFF_WINA + (size_t)1792 * 1024 * 2;
constexpr size_t OFF_WUKV = OFF_WUQ + (size_t)1536 * 384 * 2;
constexpr size_t OFF_WOUTA = OFF_WUKV + (size_t)2048 * 256 * 2;
constexpr size_t OFF_WINB = OFF_WOUTA + (size_t)1024 * 1024 * 2;
constexpr size_t OFF_WRG = OFF_WINB + (size_t)2048 * 1024 * 2;
constexpr size_t OFF_WIG = OFF_WRG + (size_t)4 * 256 * 256 * 2;
constexpr size_t OFF_WOUTB = OFF_WIG + (size_t)4 * 256 * 256 * 2;
constexpr size_t OFF_RINV0 = OFF_WOUTB + (size_t)1024 * 1024 * 2;
constexpr size_t OFF_SSQA = OFF_RINV0 + (size_t)MP * 4;
constexpr size_t OFF_SSQ1 = OFF_SSQA + (size_t)MP * 16 * 4;
constexpr size_t OFF_SSQ2 = OFF_SSQ1 + (size_t)MP * 16 * 4;
constexpr size_t OFF_ROPEC = OFF_SSQ2 + (size_t)MP * 16 * 4;
constexpr size_t OFF_ROPES = OFF_ROPEC + (size_t)TP * 32 * 4;
constexpr size_t OFF_CARA = OFF_ROPES + (size_t)TP * 32 * 4;
constexpr size_t OFF_CARB = OFF_CARA + (size_t)NB * NTB * 1024 * 4;
constexpr size_t OFF_CARIN = OFF_CARB + (size_t)NB * NTB * 1024 * 4;
constexpr size_t OFF_BAR = OFF_CARIN + (size_t)NB * NTB * 1024 * 4;
constexpr size_t WS_NEEDED = OFF_BAR + 16384;

struct Params {
  const float* x; const float* meta;
  const float* a_norm_g; const float* a_w_in; const float* a_q_norm_g; const float* a_kv_norm_g;
  const float* a_w_uq; const float* a_w_ukv; const float* a_w_out;
  const float* b_norm_g; const float* b_w_in; const float* b_conv_w; const float* b_conv_b;
  const float* b_w_rg; const float* b_b_rg; const float* b_w_ig; const float* b_b_ig;
  const float* b_lam; const float* b_w_out; const float* final_norm_g;
  float* out; char* ws;
};

DI unsigned pack2(float a, float b) { bf16v2 v = {(__bf16)a, (__bf16)b}; return __builtin_bit_cast(unsigned, v); }
DI bf16_t f2bf(float a) { __bf16 v = (__bf16)a; return __builtin_bit_cast(bf16_t, v); }
DI float bf2f(bf16_t v) { return __uint_as_float(((unsigned)v) << 16); }
DI float bflo(unsigned u) { return __uint_as_float(u << 16); }
DI float bfhi(unsigned u) { return __uint_as_float(u & 0xffff0000u); }
DI float silu_f(float v) { return v / (1.f + __expf(-v)); }
DI float sigmoid_f(float v) { return 1.f / (1.f + __expf(-v)); }
DI f32x4 mfma16(bf16x8 a, bf16x8 b, f32x4 c) { return __builtin_amdgcn_mfma_f32_16x16x32_bf16(a, b, c, 0, 0, 0); }
DI f32x16 mfma32(bf16x8 a, bf16x8 b, f32x16 c) { return __builtin_amdgcn_mfma_f32_32x32x16_bf16(a, b, c, 0, 0, 0); }
DI int st_off(int row, int kc) { return row * 128 + ((kc ^ (row & 7)) << 4); }
DI float h0_val(const Params& p, int b, int pp, int col) {
  if (pp < PAD) return 0.f;
  int pos = pp - PAD;
  return pos < NMETA ? p.meta[pos * DM + col] : p.x[((size_t)b * SEQ + (pos - NMETA)) * DM + col];
}

#define XB_TMO      128
#define XB_XCNT(j)  (256  + 64 * (j))
#define XB_XSUB(j)  (1280 + 64 * (j))
#define XB_XGEN(j)  (2304 + 64 * (j))
#define XB_TOP      3328
#define XB_TOPGEN   3392
#define XCD_BAR_WORDS 3456
#define XB_SPIN_CAP (1u << 22)
#define LAS __attribute__((address_space(3)))
DI unsigned xb_ld(unsigned* p)              { return __hip_atomic_load(p, __ATOMIC_RELAXED, __HIP_MEMORY_SCOPE_AGENT); }
DI unsigned xb_add(unsigned* p, unsigned v) { return __hip_atomic_fetch_add(p, v, __ATOMIC_RELAXED, __HIP_MEMORY_SCOPE_AGENT); }
DI unsigned xb_xcc_id() { return (unsigned)__builtin_amdgcn_s_getreg((3 << 11) | 20) & 0xFu; }
#define XB_SPIN(cond, bar) do { unsigned _sp = 0; while (cond) { __builtin_amdgcn_s_sleep(1); \
    if ((++_sp & 255u) == 0u) { if (xb_ld(&(bar)[XB_TMO])) break; if (_sp > XB_SPIN_CAP) { atomicAdd(&(bar)[XB_TMO], 1u); break; } } } } while (0)
struct XcdBarrier { unsigned* bar; unsigned x; volatile LAS unsigned* st; };
DI XcdBarrier xcd_barrier_post(unsigned* bar, volatile LAS unsigned* st) {
  XcdBarrier b; b.bar = bar; b.x = xb_xcc_id(); b.st = st;
  if (threadIdx.x == 0) (void)xb_add(&bar[XB_XCNT(b.x)], 1u);
  return b;
}
DI void xcd_barrier_complete(unsigned* bar, unsigned x, unsigned& nloc, unsigned& nx) {
  const unsigned G = gridDim.x * gridDim.y * gridDim.z;
  unsigned sum, cnt, mine, sp = 0u;
  for (;;) {
    sum = 0u; cnt = 0u; mine = 0u;
#pragma unroll
    for (unsigned j = 0; j < 16; ++j) { const unsigned c = xb_ld(&bar[XB_XCNT(j)]); sum += c; cnt += (c > 0u) ? 1u : 0u; mine = (j == x) ? c : mine; }
    if (sum == G) break;
    __builtin_amdgcn_s_sleep(1);
    if ((++sp & 255u) == 0u) { if (xb_ld(&bar[XB_TMO])) break; if (sp > XB_SPIN_CAP) { atomicAdd(&bar[XB_TMO], 1u); break; } }
  }
  nloc = mine > 0u ? mine : 1u; nx = cnt > 0u ? cnt : 1u;
}
DI void xcd_barrier(const XcdBarrier& b) {
  asm volatile("s_waitcnt vmcnt(0)" ::: "memory");
  __syncthreads();
  if (threadIdx.x == 0) {
    unsigned* bar = b.bar;
    __builtin_amdgcn_s_waitcnt(0);
    unsigned nloc = b.st[0], nx = b.st[1];
    if (nloc == 0u) { xcd_barrier_complete(bar, b.x, nloc, nx); b.st[0] = nloc; b.st[1] = nx; }
    const unsigned old = xb_add(&bar[XB_XSUB(b.x)], 1u);
    const unsigned gen = old / nloc;
    if (old + 1u == (gen + 1u) * nloc) {
      __builtin_amdgcn_fence(__ATOMIC_RELEASE, "agent");
      asm volatile("s_waitcnt vmcnt(0)" ::: "memory");
      const unsigned og = xb_add(&bar[XB_TOP], 1u);
      const unsigned tg = og / nx;
      if (og + 1u == (tg + 1u) * nx) xb_add(&bar[XB_TOPGEN], 1u);
      else XB_SPIN(xb_ld(&bar[XB_TOPGEN]) == tg, bar);
      __builtin_amdgcn_fence(__ATOMIC_ACQUIRE, "agent");
      xb_add(&bar[XB_XGEN(b.x)], 1u);
      asm volatile("s_waitcnt vmcnt(0)" ::: "memory");
    } else {
      XB_SPIN(xb_ld(&bar[XB_XGEN(b.x)]) == gen, bar);
      __builtin_amdgcn_fence(__ATOMIC_ACQUIRE, "agent");
      asm volatile("s_waitcnt vmcnt(0)" ::: "memory");
    }
  }
  __syncthreads();
}

constexpr int SMEM_MAIN = 65536;
constexpr int SMEM_AGG = 2048;
constexpr int SMEM_BYTES = SMEM_MAIN + SMEM_AGG + 16;

DI void transpose_tile(const float* src, int ldsrc, int ncols_valid, const float* gscale, bf16_t* dst, int lddst,
                       int k0, int n0, char* smem) {
  float* tile = (float*)smem;
  const int tid = threadIdx.x, tx = tid & 63, ty = tid >> 6;
  __syncthreads();
#pragma unroll 4
  for (int i = 0; i < 16; ++i) {
    int k = ty * 16 + i;
    float v = (n0 + tx < ncols_valid) ? src[(size_t)(k0 + k) * ldsrc + n0 + tx] : 0.f;
    tile[k * 65 + tx] = v;
  }
  __syncthreads();
  float g = gscale ? gscale[k0 + tx] : 1.f;
#pragma unroll 4
  for (int i = 0; i < 16; ++i) {
    int n = ty * 16 + i;
    dst[(size_t)(n0 + n) * lddst + k0 + tx] = f2bf(tile[tx * 65 + n] * g);
  }
}

DI void phase_prep(const Params& p, char* smem) {
  char* ws = p.ws;
  const int tid = threadIdx.x, lane = tid & 63, wid = tid >> 6;
  constexpr int N_WINA = 16 * 28, N_WUQ = 6 * 24, N_WUKV = 4 * 32, N_WOUTA = 256, N_WINB = 16 * 32, N_WRG = 64, N_WIG = 64, N_WOUTB = 256;
  constexpr int T0 = N_WINA, T1 = T0 + N_WUQ, T2 = T1 + N_WUKV, T3 = T2 + N_WOUTA, T4 = T3 + N_WINB, T5 = T4 + N_WRG, T6 = T5 + N_WIG, T7 = T6 + N_WOUTB;
  constexpr int N_ROWS = MP / 4;
  constexpr int N_ROPE = TP * 32 / 256;
  constexpr int TOTAL = T7 + N_ROWS + N_ROPE;
  for (int it = blockIdx.x; it < TOTAL; it += gridDim.x) {
    if (it < T7) {
      if (it < T0)      { int t = it;      transpose_tile(p.a_w_in, 1728, 1728, p.a_norm_g, (bf16_t*)(ws + OFF_WINA), 1024, (t % 16) * 64, (t / 16) * 64, smem); }
      else if (it < T1) { int t = it - T0; transpose_tile(p.a_w_uq, 1536, 1536, p.a_q_norm_g, (bf16_t*)(ws + OFF_WUQ), 384, (t % 6) * 64, (t / 6) * 64, smem); }
      else if (it < T2) { int t = it - T1; transpose_tile(p.a_w_ukv, 2048, 2048, p.a_kv_norm_g, (bf16_t*)(ws + OFF_WUKV), 256, (t % 4) * 64, (t / 4) * 64, smem); }
      else if (it < T3) { int t = it - T2; transpose_tile(p.a_w_out, 1024, 1024, nullptr, (bf16_t*)(ws + OFF_WOUTA), 1024, (t % 16) * 64, (t / 16) * 64, smem); }
      else if (it < T4) { int t = it - T3; transpose_tile(p.b_w_in, 2048, 2048, p.b_norm_g, (bf16_t*)(ws + OFF_WINB), 1024, (t % 16) * 64, (t / 16) * 64, smem); }
      else if (it < T5) { int t = it - T4; int g = t >> 4; t &= 15; transpose_tile(p.b_w_rg + g * 65536, 256, 256, nullptr, (bf16_t*)(ws + OFF_WRG) + g * 65536, 256, (t & 3) * 64, (t >> 2) * 64, smem); }
      else if (it < T6) { int t = it - T5; int g = t >> 4; t &= 15; transpose_tile(p.b_w_ig + g * 65536, 256, 256, nullptr, (bf16_t*)(ws + OFF_WIG) + g * 65536, 256, (t & 3) * 64, (t >> 2) * 64, smem); }
      else              { int t = it - T6; transpose_tile(p.b_w_out, 1024, 1024, nullptr, (bf16_t*)(ws + OFF_WOUTB), 1024, (t % 16) * 64, (t / 16) * 64, smem); }
    } else if (it < T7 + N_ROWS) {
      const int row = (it - T7) * 4 + wid;
      const int b = row / TP, pp = row % TP;
      bf16_t* dst = (bf16_t*)(ws + OFF_XN0) + (size_t)row * DM;
      float* rinv0 = (float*)(ws + OFF_RINV0);
      if (pp < PAD) {
#pragma unroll
        for (int i = 0; i < 4; ++i) *(uint2*)(dst + i * 256 + lane * 4) = make_uint2(0u, 0u);
        if (lane == 0) rinv0[row] = 0.f;
      } else {
        const int pos = pp - PAD;
        const float* src = pos < NMETA ? p.meta + pos * DM : p.x + ((size_t)b * SEQ + (pos - NMETA)) * DM;
        float ss = 0.f;
        float4 v[4];
#pragma unroll
        for (int i = 0; i < 4; ++i) { v[i] = *(const float4*)(src + i * 256 + lane * 4); ss += v[i].x * v[i].x + v[i].y * v[i].y + v[i].z * v[i].z + v[i].w * v[i].w; }
#pragma unroll
        for (int o = 32; o >= 1; o >>= 1) ss += __shfl_xor(ss, o);
#pragma unroll
        for (int i = 0; i < 4; ++i) *(uint2*)(dst + i * 256 + lane * 4) = make_uint2(pack2(v[i].x, v[i].y), pack2(v[i].z, v[i].w));
        if (lane == 0) rinv0[row] = rsqrtf(ss * (1.f / 1024.f) + RMS_EPS);
      }
    } else {
      const int e = (it - T7 - N_ROWS) * 256 + tid;
      const int pp = e >> 5, i = e & 31;
      const float inv_freq = __builtin_amdgcn_exp2f(-(float)i * (13.287712379549449f / 32.f));
      const float ang = (float)(pp - PAD) * inv_freq;
      const double rev = (double)ang * 0.15915494309189535;
      const float fr_ = (float)(rev - rint(rev));
      const float s = __builtin_amdgcn_sinf(fr_), c = __builtin_amdgcn_cosf(fr_);
      ((float*)(ws + OFF_ROPEC))[e] = c;
      ((float*)(ws + OFF_ROPES))[e] = s;
    }
  }
}

enum { M_G1 = 1, M_Q = 2, M_KV = 3, M_OUTA = 4, M_INB = 5, M_RG = 6, M_OUTB = 7 };

DI void row_ssq_store(const float (&sq)[4][4], float* ssq, int row_base, int slab, int fr, int fq) {
#pragma unroll
  for (int m = 0; m < 4; ++m)
#pragma unroll
    for (int j = 0; j < 4; ++j) {
      float v = sq[m][j];
      v += __shfl_xor(v, 1); v += __shfl_xor(v, 2); v += __shfl_xor(v, 4); v += __shfl_xor(v, 8);
      if (fr == 0) ssq[(size_t)(row_base + m * 16 + fq * 4 + j) * 16 + slab] = v;
    }
}

template <int MODE>
DI void gemm_tile(const Params& p, int mt, int nt, char* smem) {
  char* ws = p.ws;
  const int tid = threadIdx.x, lane = tid & 63, wid = tid >> 6;
  const int wr = wid >> 1, wc = wid & 1, fr = lane & 15, fq = lane >> 4;
  const int m0 = mt * 128, n0 = nt * 128;
  const int lrow = tid >> 3, lkc = tid & 7;

  const bf16_t* Ab; int lda; const bf16_t* Bb; int ldb; int nk;
  if constexpr (MODE == M_G1)   { Ab = (const bf16_t*)(ws + OFF_XN0); lda = 1024; Bb = (const bf16_t*)(ws + OFF_WINA); ldb = 1024; nk = 16; }
  if constexpr (MODE == M_Q)    { Ab = (const bf16_t*)(ws + OFF_QLAT); lda = 640; Bb = (const bf16_t*)(ws + OFF_WUQ); ldb = 384; nk = 6; }
  if constexpr (MODE == M_KV)   { Ab = (const bf16_t*)(ws + OFF_QLAT) + 384; lda = 640; Bb = (const bf16_t*)(ws + OFF_WUKV); ldb = 256; nk = 4; }
  if constexpr (MODE == M_OUTA) { Ab = (const bf16_t*)(ws + OFF_Y); lda = 1024; Bb = (const bf16_t*)(ws + OFF_WOUTA); ldb = 1024; nk = 16; }
  if constexpr (MODE == M_INB)  { Ab = (const bf16_t*)(ws + OFF_H1B); lda = 1024; Bb = (const bf16_t*)(ws + OFF_WINB); ldb = 1024; nk = 16; }
  if constexpr (MODE == M_OUTB) { Ab = (const bf16_t*)(ws + OFF_HSL); lda = 1024; Bb = (const bf16_t*)(ws + OFF_WOUTB); ldb = 1024; nk = 16; }
  if constexpr (MODE == M_RG)   { Ab = (const bf16_t*)(ws + OFF_U); lda = 1024; Bb = nullptr; ldb = 256; nk = 4; }
  const int rg_g = nt >> 2, rg_sc = nt & 3;

  const bf16_t* Ap = Ab + (size_t)(m0 + lrow) * lda + lkc * 8;
  const bf16_t* Bp = nullptr;
  if constexpr (MODE != M_RG) Bp = Bb + (size_t)(n0 + lrow) * ldb + lkc * 8;

  f32x4 acc[4][4];
#pragma unroll
  for (int m = 0; m < 4; ++m)
#pragma unroll
    for (int n = 0; n < 4; ++n) acc[m][n] = f32x4{0.f, 0.f, 0.f, 0.f};

  uint4 ra[4], rb[4];

  auto issue_loads = [&](int kt) __attribute__((always_inline)) {
    if constexpr (MODE != M_RG) {
#pragma unroll
      for (int i = 0; i < 4; ++i) ra[i] = *(const uint4*)(Ap + (size_t)(32 * i) * lda + kt * 64);
#pragma unroll
      for (int i = 0; i < 4; ++i) rb[i] = *(const uint4*)(Bp + (size_t)(32 * i) * ldb + kt * 64);
    } else {
      const int kc = (rg_sc + 1 + kt) & 3;
#pragma unroll
      for (int i = 0; i < 4; ++i) {
        const bf16_t* W = (const bf16_t*)(ws + ((i & 1) ? OFF_WIG : OFF_WRG));
        const int chl = lrow + 32 * (i >> 1);
        rb[i] = *(const uint4*)(W + (size_t)(rg_g * 256 + rg_sc * 64 + chl) * 256 + kc * 64 + lkc * 8);
      }
    }
  };
  auto commit = [&](int kt) __attribute__((always_inline)) {
    char* As = smem + (kt & 1) * 32768;
    char* Bs = As + 16384;
    if constexpr (MODE != M_RG) {
#pragma unroll
      for (int i = 0; i < 4; ++i) *(uint4*)(As + st_off(lrow + 32 * i, lkc)) = ra[i];
    } else {
      const int kc = (rg_sc + 1 + kt) & 3;
      const int ch0 = rg_g * 256 + kc * 64 + lkc * 8;
      const int r0 = lrow * 4;
      u32x4 ur[7];
#pragma unroll
      for (int q = 0; q < 7; ++q) {
        int rr = m0 + r0 - 3 + q; rr = rr < 0 ? 0 : rr;
        ur[q] = *(const u32x4*)(Ab + (size_t)rr * 1024 + ch0);
      }
      unsigned res[4][4];
#pragma unroll
      for (int cp = 0; cp < 4; ++cp) {
        const float2 bia = *(const float2*)(p.b_conv_b + ch0 + 2 * cp);
        float o0[4], o1[4];
#pragma unroll
        for (int t = 0; t < 4; ++t) { o0[t] = bia.x; o1[t] = bia.y; }
#pragma unroll
        for (int j = 0; j < 4; ++j) {
          const float2 w = *(const float2*)(p.b_conv_w + j * 1024 + ch0 + 2 * cp);
#pragma unroll
          for (int t = 0; t < 4; ++t) {
            const unsigned uu = ur[t + j][cp];
            o0[t] += w.x * bflo(uu); o1[t] += w.y * bfhi(uu);
          }
        }
#pragma unroll
        for (int t = 0; t < 4; ++t) res[t][cp] = pack2(o0[t], o1[t]);
      }
#pragma unroll
      for (int t = 0; t < 4; ++t) *(uint4*)(As + st_off(r0 + t, lkc)) = make_uint4(res[t][0], res[t][1], res[t][2], res[t][3]);
    }
#pragma unroll
    for (int i = 0; i < 4; ++i) *(uint4*)(Bs + st_off(lrow + 32 * i, lkc)) = rb[i];
  };

  __syncthreads();
  issue_loads(0);
  commit(0);
  __syncthreads();
  for (int kt = 0; kt < nk; ++kt) {
    if (kt + 1 < nk) issue_loads(kt + 1);
    {
      const char* As = smem + (kt & 1) * 32768;
      const char* Bs = As + 16384;
#pragma unroll
      for (int kk = 0; kk < 2; ++kk) {
        bf16x8 af[4], bfr[4];
#pragma unroll
        for (int m = 0; m < 4; ++m) af[m] = *(const bf16x8*)(As + st_off(wr * 64 + m * 16 + fr, kk * 4 + fq));
#pragma unroll
        for (int n = 0; n < 4; ++n) bfr[n] = *(const bf16x8*)(Bs + st_off(wc * 64 + n * 16 + fr, kk * 4 + fq));
#pragma unroll
        for (int m = 0; m < 4; ++m)
#pragma unroll
          for (int n = 0; n < 4; ++n) acc[m][n] = mfma16(af[m], bfr[n], acc[m][n]);
      }
    }
    if (kt + 1 < nk) commit(kt + 1);
    __syncthreads();
  }

  const int rbase = m0 + wr * 64;
  const int bidx = m0 / TP;
  const int ppbase = (m0 % TP) + wr * 64;
  const int slab = (n0 + wc * 64) >> 6;

  if constexpr (MODE == M_G1) {
    const float* rinv0 = (const float*)(ws + OFF_RINV0);
    float rs[4][4];
#pragma unroll
    for (int m = 0; m < 4; ++m)
#pragma unroll
      for (int j = 0; j < 4; ++j) rs[m][j] = rinv0[rbase + m * 16 + fq * 4 + j];
    if (slab < 10) {
      bf16_t* ql = (bf16_t*)(ws + OFF_QLAT);
      float sq[4][4];
#pragma unroll
      for (int m = 0; m < 4; ++m)
#pragma unroll
        for (int j = 0; j < 4; ++j) {
          float s = 0.f;
#pragma unroll
          for (int n = 0; n < 4; ++n) {
            float v = acc[m][n][j] * rs[m][j];
            s += v * v;
            ql[(size_t)(rbase + m * 16 + fq * 4 + j) * 640 + slab * 64 + n * 16 + fr] = f2bf(v);
          }
          sq[m][j] = s;
        }
      row_ssq_store(sq, (float*)(ws + OFF_SSQA), rbase, slab, fr, fq);
    } else if (slab == 10) {
      bf16_t* kr = (bf16_t*)(ws + OFF_KROPE);
      const float* rc = (const float*)(ws + OFF_ROPEC); const float* rsn = (const float*)(ws + OFF_ROPES);
#pragma unroll
      for (int m = 0; m < 4; ++m)
#pragma unroll
        for (int j = 0; j < 4; ++j) {
          const int row = rbase + m * 16 + fq * 4 + j, pp = ppbase + m * 16 + fq * 4 + j;
#pragma unroll
          for (int n = 0; n < 2; ++n) {
            const int i = n * 16 + fr;
            const float c = rc[pp * 32 + i], s = rsn[pp * 32 + i];
            const float x1 = acc[m][n][j] * rs[m][j], x2 = acc[m][n + 2][j] * rs[m][j];
            kr[(size_t)row * 64 + i] = f2bf(x1 * c - x2 * s);
            kr[(size_t)row * 64 + 32 + i] = f2bf(x1 * s + x2 * c);
          }
        }
    } else if (slab < 27) {
      bf16_t* ga = (bf16_t*)(ws + OFF_GATEA);
#pragma unroll
      for (int m = 0; m < 4; ++m)
#pragma unroll
        for (int j = 0; j < 4; ++j)
#pragma unroll
          for (int n = 0; n < 4; ++n) {
            float v = acc[m][n][j] * rs[m][j];
            ga[(size_t)(rbase + m * 16 + fq * 4 + j) * 1024 + (slab - 11) * 64 + n * 16 + fr] = f2bf(silu_f(v));
          }
    }
  }

  if constexpr (MODE == M_Q) {
    const float* ssqa = (const float*)(ws + OFF_SSQA);
    const float* rc = (const float*)(ws + OFF_ROPEC); const float* rsn = (const float*)(ws + OFF_ROPES);
    bf16_t* Q = (bf16_t*)(ws + OFF_Q);
    const int head = slab / 3, part = slab % 3;
#pragma unroll
    for (int m = 0; m < 4; ++m)
#pragma unroll
      for (int j = 0; j < 4; ++j) {
        const int row = rbase + m * 16 + fq * 4 + j, pp = ppbase + m * 16 + fq * 4 + j;
        const float* sp = ssqa + (size_t)row * 16;
        const float ss = sp[0] + sp[1] + sp[2] + sp[3] + sp[4] + sp[5];
        const float sc = rsqrtf(ss * (1.f / 384.f) + RMS_EPS) * QSCALE;
        bf16_t* qrow = Q + ((size_t)(bidx * 8 + head) * TP + pp) * 192;
        if (part < 2) {
#pragma unroll
          for (int n = 0; n < 4; ++n) qrow[part * 64 + n * 16 + fr] = f2bf(acc[m][n][j] * sc);
        } else {
#pragma unroll
          for (int n = 0; n < 2; ++n) {
            const int i = n * 16 + fr;
            const float c = rc[pp * 32 + i], s = rsn[pp * 32 + i];
            const float x1 = acc[m][n][j] * sc, x2 = acc[m][n + 2][j] * sc;
            qrow[128 + i] = f2bf(x1 * c - x2 * s);
            qrow[160 + i] = f2bf(x1 * s + x2 * c);
          }
        }
      }
  }

  if constexpr (MODE == M_KV) {
    const float* ssqa = (const float*)(ws + OFF_SSQA);
    const int head = nt >> 1, isv = nt & 1;
#pragma unroll
    for (int m = 0; m < 4; ++m) {
      float sc[4];
#pragma unroll
      for (int j = 0; j < 4; ++j) {
        const float* sp = ssqa + (size_t)(rbase + m * 16 + fq * 4 + j) * 16;
        sc[j] = rsqrtf((sp[6] + sp[7] + sp[8] + sp[9]) * (1.f / 256.f) + RMS_EPS);
      }
      const int pp = ppbase + m * 16 + fq * 4;
      if (!isv) {
        bf16_t* KN = (bf16_t*)(ws + OFF_KN) + ((size_t)(bidx * 8 + head) * TP + pp) * 128;
#pragma unroll
        for (int j = 0; j < 4; ++j)
#pragma unroll
          for (int n = 0; n < 4; ++n) KN[(size_t)j * 128 + wc * 64 + n * 16 + fr] = f2bf(acc[m][n][j] * sc[j]);
      } else {
        bf16_t* VT = (bf16_t*)(ws + OFF_VT) + (size_t)(bidx * 8 + head) * 128 * TP + pp;
#pragma unroll
        for (int n = 0; n < 4; ++n) {
          const int c = wc * 64 + n * 16 + fr;
          *(uint2*)(VT + (size_t)c * TP) = make_uint2(pack2(acc[m][n][0] * sc[0], acc[m][n][1] * sc[1]), pack2(acc[m][n][2] * sc[2], acc[m][n][3] * sc[3]));
        }
      }
    }
  }

  if constexpr (MODE == M_OUTA) {
    float* H1 = (float*)(ws + OFF_H1);
    bf16_t* H1B = (bf16_t*)(ws + OFF_H1B);
    float sq[4][4];
#pragma unroll
    for (int m = 0; m < 4; ++m)
#pragma unroll
      for (int j = 0; j < 4; ++j) {
        const int row = rbase + m * 16 + fq * 4 + j, pp = ppbase + m * 16 + fq * 4 + j;
        float s = 0.f;
#pragma unroll
        for (int n = 0; n < 4; ++n) {
          const int col = n0 + wc * 64 + n * 16 + fr;
          const float v = acc[m][n][j] + h0_val(p, bidx, pp, col);
          H1[(size_t)row * 1024 + col] = v;
          H1B[(size_t)row * 1024 + col] = f2bf(v);
          s += v * v;
        }
        sq[m][j] = s;
      }
    row_ssq_store(sq, (float*)(ws + OFF_SSQ1), rbase, slab, fr, fq);
  }

  if constexpr (MODE == M_INB) {
    const float* ssq1 = (const float*)(ws + OFF_SSQ1);
    bf16_t* dstb = (bf16_t*)(ws + (nt < 8 ? OFF_U : OFF_GATEB));
    const int cbase = (nt & 7) * 128 + wc * 64;
#pragma unroll
    for (int m = 0; m < 4; ++m)
#pragma unroll
      for (int j = 0; j < 4; ++j) {
        const int row = rbase + m * 16 + fq * 4 + j;
        const float4* sp = (const float4*)(ssq1 + (size_t)row * 16);
        const float4 a = sp[0], b = sp[1], c = sp[2], d = sp[3];
        const float ss = (a.x + a.y + a.z + a.w) + (b.x + b.y + b.z + b.w) + (c.x + c.y + c.z + c.w) + (d.x + d.y + d.z + d.w);
        const float sc = rsqrtf(ss * (1.f / 1024.f) + RMS_EPS);
#pragma unroll
        for (int n = 0; n < 4; ++n) {
          float v = acc[m][n][j] * sc;
          if (nt >= 8) v = silu_f(v);
          dstb[(size_t)row * 1024 + cbase + n * 16 + fr] = f2bf(v);
        }
      }
  }

  if constexpr (MODE == M_OUTB) {
    float* H1 = (float*)(ws + OFF_H1);
    float sq[4][4];
#pragma unroll
    for (int m = 0; m < 4; ++m)
#pragma unroll
      for (int j = 0; j < 4; ++j) {
        const int row = rbase + m * 16 + fq * 4 + j;
        float s = 0.f;
#pragma unroll
        for (int n = 0; n < 4; ++n) {
          const int col = n0 + wc * 64 + n * 16 + fr;
          const float v = acc[m][n][j] + H1[(size_t)row * 1024 + col];
          H1[(size_t)row * 1024 + col] = v;
          s += v * v;
        }
        sq[m][j] = s;
      }
    row_ssq_store(sq, (float*)(ws + OFF_SSQ2), rbase, slab, fr, fq);
  }

  if constexpr (MODE == M_RG) {
    const char* Auc = smem + 32768;
    float uc[4][2][4];
#pragma unroll
    for (int n = 0; n < 2; ++n)
#pragma unroll
      for (int j = 0; j < 4; ++j) {
        const int c = wc * 32 + n * 16 + fr;
        const int ub = (wr * 64 + fq * 4 + j) * 128 + (((c >> 3) ^ ((fq & 1) * 4 + j)) << 4) + (c & 7) * 2;
#pragma unroll
        for (int m = 0; m < 4; ++m) uc[m][n][j] = bf2f(*(const bf16_t*)(Auc + ub + m * 2048));
      }
    __syncthreads();
    float* SA = (float*)smem;
    float* SB = (float*)(smem + 32768);
    float* AGG = (float*)(smem + SMEM_MAIN);
    const int chg = rg_g * 256 + rg_sc * 64;
#pragma unroll
    for (int n = 0; n < 2; ++n) {
      const int c = wc * 32 + n * 16 + fr, ch = chg + c;
      const float brg = p.b_b_rg[ch], big = p.b_b_ig[ch];
      const int sbase = (wr * 64 + fq * 4) * 64 + (c ^ (fq << 4));
#pragma unroll
      for (int m = 0; m < 4; ++m)
#pragma unroll
        for (int j = 0; j < 4; ++j) {
          SA[sbase + (m * 16 + j) * 64] = acc[m][n][j] + brg;
          SB[sbase + (m * 16 + j) * 64] = sigmoid_f(acc[m][n + 2][j] + big) * uc[m][n][j];
        }
    }
    __syncthreads();
    {
      const int c = tid & 63, q = tid >> 6;
      float spl8;
      { const float lam = p.b_lam[chg + c]; const float z = __expf(-lam);
        const float sp = lam < -20.f ? -lam : (z < 1e-2f ? z * (1.f - z * (0.5f - z * (1.f / 3.f))) : __logf(1.f + z));
        spl8 = -8.f * sp; }
      const int ppt = (m0 % TP);
      float P = 1.f, h = 0.f;
#pragma unroll 1
      for (int t = q * 32; t < q * 32 + 32; ++t) {
        const int idx = t * 64 + (c ^ (((t >> 2) & 3) << 4));
        const float r = sigmoid_f(SA[idx]);
        const float log_a = spl8 * r;
        const float em = log_a > -0.25f ? log_a * (1.f + log_a * (0.5f + log_a * ((1.f / 6.f) + log_a * ((1.f / 24.f) + log_a * ((1.f / 120.f) + log_a * (1.f / 720.f))))))
                                         : __expf(log_a) - 1.f;
        float a = 1.f + em;
        float mult = sqrtf(fmaxf(-em * (2.f + em), 0.f));
        const int pp = ppt + t;
        if (pp == PAD) mult = 1.f;
        float bb = mult * SB[idx];
        if (pp < PAD) { a = 1.f; bb = 0.f; }
        h = a * h + bb; P = a * P;
        SA[idx] = P; SB[idx] = h;
      }
      AGG[q * 64 + c] = P; AGG[256 + q * 64 + c] = h;
      __syncthreads();
      float cin = 0.f, Ppre = 1.f;
      for (int qq = 0; qq < q; ++qq) { const float Pq = AGG[qq * 64 + c], hq = AGG[256 + qq * 64 + c]; cin = Pq * cin + hq; Ppre *= Pq; }
      if (q == 3) {
        const float At = Ppre * P, Bt = P * cin + h;
        const int j = (m0 % TP) >> 7;
        ((float*)(ws + OFF_CARA))[((size_t)bidx * NTB + j) * 1024 + chg + c] = At;
        ((float*)(ws + OFF_CARB))[((size_t)bidx * NTB + j) * 1024 + chg + c] = Bt;
      }
      bf16_t* HSL = (bf16_t*)(ws + OFF_HSL); bf16_t* PC = (bf16_t*)(ws + OFF_PCUM);
#pragma unroll 1
      for (int t = q * 32; t < q * 32 + 32; ++t) {
        const int idx = t * 64 + (c ^ (((t >> 2) & 3) << 4));
        const float Pl = SA[idx], hl = SB[idx];
        HSL[(size_t)(m0 + t) * 1024 + chg + c] = f2bf(hl + Pl * cin);
        PC[(size_t)(m0 + t) * 1024 + chg + c] = f2bf(Pl * Ppre);
      }
    }
  }
}

template <int MODE>
DI void gemm_phase(const Params& p, int ntn, char* smem) {
  const int total = NMT * ntn;
  for (int t = blockIdx.x; t < total; t += gridDim.x) {
    gemm_tile<MODE>(p, t / ntn, t % ntn, smem);
  }
}

DI void phase_qkv(const Params& p, char* smem) {
  const int total = NMT * 28;
  for (int t = blockIdx.x; t < total; t += gridDim.x) {
    const int mt = t / 28, n = t % 28;
    if (n < 12) gemm_tile<M_Q>(p, mt, n, smem); else gemm_tile<M_KV>(p, mt, n - 12, smem);
  }
}

DI int koff(int key, int ch) { return key * 384 + (((ch & ~7) | ((ch ^ (key >> 1)) & 7)) << 4); }
DI int voff(int dv, int ch) { return dv * 128 + ((ch ^ ((dv >> 1) & 7)) << 4); }

DI void attn_item(const Params& p, int b, int h, int qt, char* smem) {
  char* ws = p.ws;
  const int tid = threadIdx.x, lane = tid & 63, w = tid >> 6;
  const int r = lane & 31, hh = lane >> 5;
  const int q_pp = qt * 128 + w * 32 + r;
  const int bh = b * 8 + h;
  bf16x8 qf[12];
  {
    const bf16_t* Qp = (const bf16_t*)(ws + OFF_Q) + ((size_t)bh * TP + q_pp) * 192 + hh * 8;
#pragma unroll
    for (int ks = 0; ks < 12; ++ks) qf[ks] = *(const bf16x8*)(Qp + ks * 16);
  }
  f32x16 o[4];
#pragma unroll
  for (int d = 0; d < 4; ++d)
#pragma unroll
    for (int i = 0; i < 16; ++i) o[d][i] = 0.f;
  float m_i = -INFINITY, l_i = 0.f;
  char* Ks = smem; char* Vs = smem + 24576;
  const bf16_t* KNb = (const bf16_t*)(ws + OFF_KN) + (size_t)bh * TP * 128;
  const bf16_t* KRb = (const bf16_t*)(ws + OFF_KROPE) + (size_t)b * TP * 64;
  const bf16_t* VTb = (const bf16_t*)(ws + OFF_VT) + (size_t)bh * 128 * TP;
  const int pir = (r & 19) | ((r & 4) << 1) | ((r & 8) >> 1);
  const int nlast = 2 * qt + 1;
  for (int kt = 1; kt <= nlast; ++kt) {
    __syncthreads();
    {
      uint4 t[10];
#pragma unroll
      for (int i = 0; i < 4; ++i) { const int c = tid + 256 * i, key = c >> 4, ch = c & 15; t[i] = *(const uint4*)(KNb + (size_t)(kt * 64 + key) * 128 + ch * 8); }
#pragma unroll
      for (int i = 0; i < 2; ++i) { const int c = tid + 256 * i, key = c >> 3, ch = c & 7; t[4 + i] = *(const uint4*)(KRb + (size_t)(kt * 64 + key) * 64 + ch * 8); }
#pragma unroll
      for (int i = 0; i < 4; ++i) { const int c = tid + 256 * i, dv = c >> 3, ch = c & 7; t[6 + i] = *(const uint4*)(VTb + (size_t)dv * TP + kt * 64 + ch * 8); }
#pragma unroll
      for (int i = 0; i < 4; ++i) { const int c = tid + 256 * i, key = c >> 4, ch = c & 15; *(uint4*)(Ks + koff(key, ch)) = t[i]; }
#pragma unroll
      for (int i = 0; i < 2; ++i) { const int c = tid + 256 * i, key = c >> 3, ch = 16 + (c & 7); *(uint4*)(Ks + koff(key, ch)) = t[4 + i]; }
#pragma unroll
      for (int i = 0; i < 4; ++i) { const int c = tid + 256 * i, dv = c >> 3, ch = c & 7; *(uint4*)(Vs + voff(dv, ch)) = t[6 + i]; }
    }
    __syncthreads();
    const int kmin = kt * 64;
    const int wq0 = qt * 128 + w * 32;
    if (kmin > wq0 + 31) continue;
    f32x16 s0, s1;
#pragma unroll
    for (int i = 0; i < 16; ++i) { s0[i] = 0.f; s1[i] = 0.f; }
#pragma unroll
    for (int ks = 0; ks < 12; ++ks) {
      const bf16x8 a0 = *(const bf16x8*)(Ks + koff(pir, ks * 2 + hh));
      const bf16x8 a1 = *(const bf16x8*)(Ks + koff(32 + pir, ks * 2 + hh));
      s0 = mfma32(a0, qf[ks], s0);
      s1 = mfma32(a1, qf[ks], s1);
    }
    if (kt == 1 || kmin + 63 > wq0) {
#pragma unroll
      for (int i = 0; i < 16; ++i) {
        const int kl = (i & 3) + 4 * ((i >> 2) & 1) + 8 * hh + 16 * ((i >> 3) & 1);
        const int k0 = kmin + kl, k1 = kmin + 32 + kl;
        if (!(k0 <= q_pp && k0 >= PAD)) s0[i] = -1e30f;
        if (!(k1 <= q_pp && k1 >= PAD)) s1[i] = -1e30f;
      }
    }
    float mx = s0[0];
#pragma unroll
    for (int i = 1; i < 16; ++i) mx = fmaxf(mx, s0[i]);
#pragma unroll
    for (int i = 0; i < 16; ++i) mx = fmaxf(mx, s1[i]);
    mx = fmaxf(mx, __shfl_xor(mx, 32));
    const float m_new = fmaxf(m_i, mx);
    const float alpha = __builtin_amdgcn_exp2f(m_i - m_new);
    m_i = m_new;
    float rsum = 0.f;
#pragma unroll
    for (int i = 0; i < 16; ++i) { s0[i] = __builtin_amdgcn_exp2f(s0[i] - m_new); rsum += s0[i]; }
#pragma unroll
    for (int i = 0; i < 16; ++i) { s1[i] = __builtin_amdgcn_exp2f(s1[i] - m_new); rsum += s1[i]; }
    l_i = l_i * alpha + rsum;
#pragma unroll
    for (int d = 0; d < 4; ++d)
#pragma unroll
      for (int i = 0; i < 16; ++i) o[d][i] *= alpha;
#pragma unroll
    for (int t2 = 0; t2 < 2; ++t2)
#pragma unroll
      for (int sp = 0; sp < 2; ++sp) {
        const f32x16& sx = t2 ? s1 : s0;
        const uint4 pk = make_uint4(pack2(sx[8 * sp + 0], sx[8 * sp + 1]), pack2(sx[8 * sp + 2], sx[8 * sp + 3]),
                                    pack2(sx[8 * sp + 4], sx[8 * sp + 5]), pack2(sx[8 * sp + 6], sx[8 * sp + 7]));
        const bf16x8 pf = __builtin_bit_cast(bf16x8, pk);
        const int ch = (2 * t2 + sp) * 2 + hh;
#pragma unroll
        for (int d = 0; d < 4; ++d) {
          const bf16x8 vf = *(const bf16x8*)(Vs + voff(d * 32 + r, ch));
          o[d] = mfma32(vf, pf, o[d]);
        }
      }
  }
  const float ltot = l_i + __shfl_xor(l_i, 32);
  const float inv = 1.f / ltot;
  const size_t row = (size_t)b * TP + q_pp;
  const bf16_t* ga = (const bf16_t*)(ws + OFF_GATEA) + row * 1024 + h * 128;
  bf16_t* y = (bf16_t*)(ws + OFF_Y) + row * 1024 + h * 128;
#pragma unroll
  for (int d = 0; d < 4; ++d)
#pragma unroll
    for (int g4 = 0; g4 < 4; ++g4) {
      const int dv0 = d * 32 + 8 * g4 + 4 * hh;
      const uint2 gv = *(const uint2*)(ga + dv0);
      const float y0 = o[d][4 * g4 + 0] * inv * bflo(gv.x), y1 = o[d][4 * g4 + 1] * inv * bfhi(gv.x);
      const float y2 = o[d][4 * g4 + 2] * inv * bflo(gv.y), y3 = o[d][4 * g4 + 3] * inv * bfhi(gv.y);
      *(uint2*)(y + dv0) = make_uint2(pack2(y0, y1), pack2(y2, y3));
    }
}

DI void phase_attn(const Params& p, char* smem) {
  constexpr int total = NB * 8 * NTB;
  for (int it = blockIdx.x; it < total; it += gridDim.x) {
    const int qt = NTB - 1 - it / 64, bh = it % 64;
    attn_item(p, bh >> 3, bh & 7, qt, smem);
  }
}

DI void phase_rg2(const Params& p) {
  char* ws = p.ws;
  const int gt = blockIdx.x * 256 + threadIdx.x;
  if (gt < NB * 1024) {
    const int b = gt >> 10, ch = gt & 1023;
    const float* CA = (const float*)(ws + OFF_CARA) + (size_t)b * NTB * 1024 + ch;
    const float* CB = (const float*)(ws + OFF_CARB) + (size_t)b * NTB * 1024 + ch;
    float* CI = (float*)(ws + OFF_CARIN) + (size_t)b * NTB * 1024 + ch;
    float c = 0.f;
    for (int j = 0; j < NTB; ++j) { CI[j * 1024] = c; c = CA[j * 1024] * c + CB[j * 1024]; }
  }
}

DI void phase_rg3(const Params& p) {
  char* ws = p.ws;
  const size_t total = (size_t)MP * 128;
  bf16_t* HSL = (bf16_t*)(ws + OFF_HSL);
  const bf16_t* PC = (const bf16_t*)(ws + OFF_PCUM);
  const bf16_t* GB = (const bf16_t*)(ws + OFF_GATEB);
  const float* CI = (const float*)(ws + OFF_CARIN);
  for (size_t e = (size_t)blockIdx.x * 256 + threadIdx.x; e < total; e += (size_t)gridDim.x * 256) {
    const int row = (int)(e >> 7), c8 = (int)(e & 127) * 8;
    const int b = row / TP, j = (row % TP) >> 7;
    const uint4 hv = *(const uint4*)(HSL + (size_t)row * 1024 + c8);
    const uint4 pv = *(const uint4*)(PC + (size_t)row * 1024 + c8);
    const uint4 gv = *(const uint4*)(GB + (size_t)row * 1024 + c8);
    const float4 c0 = *(const float4*)(CI + ((size_t)b * NTB + j) * 1024 + c8), c1 = *(const float4*)(CI + ((size_t)b * NTB + j) * 1024 + c8 + 4);
    uint4 ov;
    ov.x = pack2((bflo(hv.x) + bflo(pv.x) * c0.x) * bflo(gv.x), (bfhi(hv.x) + bfhi(pv.x) * c0.y) * bfhi(gv.x));
    ov.y = pack2((bflo(hv.y) + bflo(pv.y) * c0.z) * bflo(gv.y), (bfhi(hv.y) + bfhi(pv.y) * c0.w) * bfhi(gv.y));
    ov.z = pack2((bflo(hv.z) + bflo(pv.z) * c1.x) * bflo(gv.z), (bfhi(hv.z) + bfhi(pv.z) * c1.y) * bfhi(gv.z));
    ov.w = pack2((bflo(hv.w) + bflo(pv.w) * c1.z) * bflo(gv.w), (bfhi(hv.w) + bfhi(pv.w) * c1.w) * bfhi(gv.w));
    *(uint4*)(HSL + (size_t)row * 1024 + c8) = ov;
  }
}

DI void phase_final(const Params& p) {
  char* ws = p.ws;
  const int lane = threadIdx.x & 63, wid = threadIdx.x >> 6;
  const float* H = (const float*)(ws + OFF_H1);
  const float* ssq2 = (const float*)(ws + OFF_SSQ2);
  for (int it = blockIdx.x; it < NB * SEQ / 4; it += gridDim.x) {
    const int orow = it * 4 + wid;
    const int b = orow >> 12, s = orow & 4095;
    const int row = b * TP + PAD + NMETA + s;
    float ss = 0.f;
    { const float v = (lane < 16) ? ssq2[(size_t)row * 16 + lane] : 0.f; ss = v; }
#pragma unroll
    for (int o = 8; o >= 1; o >>= 1) ss += __shfl_xor(ss, o);
    ss = __shfl(ss, 0);
    const float sc = rsqrtf(ss * (1.f / 1024.f) + RMS_EPS);
#pragma unroll
    for (int i = 0; i < 4; ++i) {
      const int col = i * 256 + lane * 4;
      const float4 v = *(const float4*)(H + (size_t)row * 1024 + col);
      const float4 g = *(const float4*)(p.final_norm_g + col);
      *(float4*)(p.out + (size_t)orow * 1024 + col) = make_float4(v.x * sc * g.x, v.y * sc * g.y, v.z * sc * g.z, v.w * sc * g.w);
    }
  }
}

constexpr int N_PHASES = 11;

__global__ void __launch_bounds__(256, 2) fwd_mega(Params p, int ph_lo, int ph_hi, int coop) {
  __shared__ __attribute__((aligned(16))) char smem[SMEM_BYTES];
  XcdBarrier xb;
  if (coop) {
    if (threadIdx.x < 4) { ((volatile unsigned*)(smem + SMEM_MAIN + SMEM_AGG))[threadIdx.x] = 0u; }
    __syncthreads();
    xb = xcd_barrier_post((unsigned*)(p.ws + OFF_BAR), (volatile LAS unsigned*)(smem + SMEM_MAIN + SMEM_AGG));
    if (coop == 2) cg::this_grid().sync();
  }
#ifndef ONLY_PHASE
#define ONLY_PHASE -1
#endif
#define RUN_PHASE(k, call) if ((ONLY_PHASE < 0 || ONLY_PHASE == (k)) && ph_lo <= (k) && (k) < ph_hi) { call; if (coop && (k) + 1 < ph_hi) xcd_barrier(xb); }
  RUN_PHASE(0, phase_prep(p, smem))
  RUN_PHASE(1, gemm_phase<M_G1>(p, 14, smem))
  RUN_PHASE(2, phase_qkv(p, smem))
  RUN_PHASE(3, phase_attn(p, smem))
  RUN_PHASE(4, gemm_phase<M_OUTA>(p, 8, smem))
  RUN_PHASE(5, gemm_phase<M_INB>(p, 16, smem))
  RUN_PHASE(6, gemm_phase<M_RG>(p, 16, smem))
  RUN_PHASE(7, phase_rg2(p))
  RUN_PHASE(8, phase_rg3(p))
  RUN_PHASE(9, gemm_phase<M_OUTB>(p, 8, smem))
  RUN_PHASE(10, phase_final(p))
}

extern "C" void kernel_launch(void* const* d_in, const int* in_sizes, int n_in, void* d_out, int out_size, void* d_ws,
                              size_t ws_size, hipStream_t stream) {
  static int grid_blocks = 0;
  if (!grid_blocks) {
    int dev = 0, cus = 0, per_cu = 0;
    (void)hipGetDevice(&dev);
    (void)hipDeviceGetAttribute(&cus, hipDeviceAttributeMultiprocessorCount, dev);
    (void)hipOccupancyMaxActiveBlocksPerMultiprocessor(&per_cu, fwd_mega, 256, 0);
    if (per_cu > 2) per_cu = 2;
    if (per_cu < 1) per_cu = 1;
    grid_blocks = cus * per_cu;
  }
  if (ws_size < WS_NEEDED) { fprintf(stderr, "workspace too small: %zu < %zu\n", ws_size, (size_t)WS_NEEDED); return; }
  Params p{};
  p.x = (const float*)d_in[0]; p.meta = (const float*)d_in[1];
  p.a_norm_g = (const float*)d_in[2]; p.a_w_in = (const float*)d_in[3]; p.a_q_norm_g = (const float*)d_in[4];
  p.a_kv_norm_g = (const float*)d_in[5]; p.a_w_uq = (const float*)d_in[6]; p.a_w_ukv = (const float*)d_in[7];
  p.a_w_out = (const float*)d_in[8]; p.b_norm_g = (const float*)d_in[9]; p.b_w_in = (const float*)d_in[10];
  p.b_conv_w = (const float*)d_in[11]; p.b_conv_b = (const float*)d_in[12]; p.b_w_rg = (const float*)d_in[13];
  p.b_b_rg = (const float*)d_in[14]; p.b_w_ig = (const float*)d_in[15]; p.b_b_ig = (const float*)d_in[16];
  p.b_lam = (const float*)d_in[17]; p.b_w_out = (const float*)d_in[18]; p.final_norm_g = (const float*)d_in[19];
  p.out = (float*)d_out; p.ws = (char*)d_ws;
#if SINGLE_LAUNCH
  (void)hipMemsetAsync((char*)d_ws + OFF_BAR, 0, XCD_BAR_WORDS * 4, stream);
  int lo = 0, hi = N_PHASES, coop = 1;
  void* args[] = {&p, &lo, &hi, &coop};
  hipError_t e = hipLaunchCooperativeKernel((void*)fwd_mega, dim3(grid_blocks), dim3(256), args, 0, stream);
  if (e != hipSuccess) fprintf(stderr, "cooperative launch failed: %s (grid %d)\n", hipGetErrorString(e), grid_blocks);
#else
  for (int ph = 0; ph < N_PHASES; ++ph) fwd_mega<<<grid_blocks, 256, 0, stream>>>(p, ph, ph + 1, 0);
#endif
}
```

```cpp
#include <hip/hip_runtime.h>
#include <hip/hip_cooperative_groups.h>
#include <cstdio>
#include <cstdint>
namespace cg = cooperative_groups;

#ifndef SINGLE_LAUNCH
#define SINGLE_LAUNCH 1
#endif

#define DI __device__ __forceinline__
typedef unsigned short bf16_t;
using bf16x8 = __attribute__((ext_vector_type(8))) short;
using f32x4  = __attribute__((ext_vector_type(4))) float;
using f32x16 = __attribute__((ext_vector_type(16))) float;
using u32x4 = __attribute__((ext_vector_type(4))) unsigned;
typedef __bf16 bf16v2 __attribute__((ext_vector_type(2)));

constexpr int NB = 8, SEQ = 4096, NMETA = 16;
constexpr int TP = 4224;
constexpr int PAD = 112;
constexpr int MP = NB * TP;
constexpr int NMT = MP / 128;
constexpr int DM = 1024;
constexpr int NTB = TP / 128;
constexpr float RMS_EPS = 1e-6f;
constexpr float QSCALE = 0.07216878364870322f * 1.4426950408889634f;

constexpr size_t SZ = (size_t)MP * 1024 * 2;
constexpr size_t OFF_XN0 = 0;
constexpr size_t OFF_Y = 0;
constexpr size_t OFF_U = 0;
constexpr size_t OFF_QLAT = SZ;
constexpr size_t OFF_GATEB = SZ;
constexpr size_t OFF_GATEA = 2 * SZ;
constexpr size_t OFF_H1B = 2 * SZ;
constexpr size_t OFF_HSL = 2 * SZ;
constexpr size_t OFF_Q = 3 * SZ;
constexpr size_t OFF_KN = 4 * SZ + SZ / 2;
constexpr size_t OFF_VT = 5 * SZ + SZ / 2;
constexpr size_t OFF_H1 = 3 * SZ;
constexpr size_t OFF_PCUM = 5 * SZ;
constexpr size_t OFF_MISC = 6 * SZ + SZ / 2;
constexpr size_t OFF_KROPE = OFF_MISC;
constexpr size_t OFF_WINA = OFF_KROPE + (size_t)MP * 64 * 2;
constexpr size_t OFF_WUQ = OFF_WINA + (size_t)1792 * 1024 * 2;
constexpr size_t OFF_WUKV = OFF_WUQ + (size_t)1536 * 384 * 2;
constexpr size_t OFF_WOUTA = OFF_WUKV + (size_t)2048 * 256 * 2;
constexpr size_t OFF_WINB = OFF_WOUTA + (size_t)1024 * 1024 * 2;
constexpr size_t OFF_WRG = OFF_WINB + (size_t)2048 * 1024 * 2;
constexpr size_t OFF_WIG = OFF_WRG + (size_t)4 * 256 * 256 * 2;
constexpr size_t OFF_WOUTB = OFF_WIG + (size_t)4 * 256 * 256 * 2;
constexpr size_t OFF_RINV0 = OFF_WOUTB + (size_t)1024 * 1024 * 2;
constexpr size_t OFF_SSQA = OFF_RINV0 + (size_t)MP * 4;
constexpr size_t OFF_SSQ1 = OFF_SSQA + (size_t)MP * 16 * 4;
constexpr size_t OFF_SSQ2 = OFF_SSQ1 + (size_t)MP * 16 * 4;
constexpr size_t OFF_ROPEC = OFF_SSQ2 + (size_t)MP * 16 * 4;
constexpr size_t OFF_ROPES = OFF_ROPEC + (size_t)TP * 32 * 4;
constexpr size_t OFF_CARA = OFF_ROPES + (size_t)TP * 32 * 4;
constexpr size_t OFF_CARB = OFF_CARA + (size_t)NB * NTB * 1024 * 4;
constexpr size_t OFF_CARIN = OFF_CARB + (size_t)NB * NTB * 1024 * 4;
constexpr size_t OFF_BAR = OFF_CARIN + (size_t)NB * NTB * 1024 * 4;
constexpr size_t WS_NEEDED = OFF_BAR + 16384;

struct Params {
  const float* x; const float* meta;
  const float* a_norm_g; const float* a_w_in; const float* a_q_norm_g; const float* a_kv_norm_g;
  const float* a_w_uq; const float* a_w_ukv; const float* a_w_out;
  const float* b_norm_g; const float* b_w_in; const float* b_conv_w; const float* b_conv_b;
  const float* b_w_rg; const float* b_b_rg; const float* b_w_ig; const float* b_b_ig;
  const float* b_lam; const float* b_w_out; const float* final_norm_g;
  float* out; char* ws;
};

DI unsigned pack2(float a, float b) { bf16v2 v = {(__bf16)a, (__bf16)b}; return __builtin_bit_cast(unsigned, v); }
DI bf16_t f2bf(float a) { __bf16 v = (__bf16)a; return __builtin_bit_cast(bf16_t, v); }
DI float bf2f(bf16_t v) { return __uint_as_float(((unsigned)v) << 16); }
DI float bflo(unsigned u) { return __uint_as_float(u << 16); }
DI float bfhi(unsigned u) { return __uint_as_float(u & 0xffff0000u); }
DI float silu_f(float v) { return v / (1.f + __expf(-v)); }
DI float sigmoid_f(float v) { return 1.f / (1.f + __expf(-v)); }
DI f32x4 mfma16(bf16x8 a, bf16x8 b, f32x4 c) { return __builtin_amdgcn_mfma_f32_16x16x32_bf16(a, b, c, 0, 0, 0); }
DI f32x16 mfma32(bf16x8 a, bf16x8 b, f32x16 c) { return __builtin_amdgcn_mfma_f32_32x32x16_bf16(a, b, c, 0, 0, 0); }
DI int st_off(int row, int kc) { return row * 128 + ((kc ^ (row & 7)) << 4); }
DI float h0_val(const Params& p, int b, int pp, int col) {
  if (pp < PAD) return 0.f;
  int pos = pp - PAD;
  return pos < NMETA ? p.meta[pos * DM + col] : p.x[((size_t)b * SEQ + (pos - NMETA)) * DM + col];
}

#define XB_TMO      128
#define XB_XCNT(j)  (256  + 64 * (j))
#define XB_XSUB(j)  (1280 + 64 * (j))
#define XB_XGEN(j)  (2304 + 64 * (j))
#define XB_TOP      3328
#define XB_TOPGEN   3392
#define XCD_BAR_WORDS 3456
#define XB_SPIN_CAP (1u << 22)
#define LAS __attribute__((address_space(3)))
DI unsigned xb_ld(unsigned* p)              { return __hip_atomic_load(p, __ATOMIC_RELAXED, __HIP_MEMORY_SCOPE_AGENT); }
DI unsigned xb_add(unsigned* p, unsigned v) { return __hip_atomic_fetch_add(p, v, __ATOMIC_RELAXED, __HIP_MEMORY_SCOPE_AGENT); }
DI unsigned xb_xcc_id() { return (unsigned)__builtin_amdgcn_s_getreg((3 << 11) | 20) & 0xFu; }
#define XB_SPIN(cond, bar) do { unsigned _sp = 0; while (cond) { __builtin_amdgcn_s_sleep(1); \
    if ((++_sp & 255u) == 0u) { if (xb_ld(&(bar)[XB_TMO])) break; if (_sp > XB_SPIN_CAP) { atomicAdd(&(bar)[XB_TMO], 1u); break; } } } } while (0)
struct XcdBarrier { unsigned* bar; unsigned x; volatile LAS unsigned* st; };
DI XcdBarrier xcd_barrier_post(unsigned* bar, volatile LAS unsigned* st) {
  XcdBarrier b; b.bar = bar; b.x = xb_xcc_id(); b.st = st;
  if (threadIdx.x == 0) (void)xb_add(&bar[XB_XCNT(b.x)], 1u);
  return b;
}
DI void xcd_barrier_complete(unsigned* bar, unsigned x, unsigned& nloc, unsigned& nx) {
  const unsigned G = gridDim.x * gridDim.y * gridDim.z;
  unsigned sum, cnt, mine, sp = 0u;
  for (;;) {
    sum = 0u; cnt = 0u; mine = 0u;
#pragma unroll
    for (unsigned j = 0; j < 16; ++j) { const unsigned c = xb_ld(&bar[XB_XCNT(j)]); sum += c; cnt += (c > 0u) ? 1u : 0u; mine = (j == x) ? c : mine; }
    if (sum == G) break;
    __builtin_amdgcn_s_sleep(1);
    if ((++sp & 255u) == 0u) { if (xb_ld(&bar[XB_TMO])) break; if (sp > XB_SPIN_CAP) { atomicAdd(&bar[XB_TMO], 1u); break; } }
  }
  nloc = mine > 0u ? mine : 1u; nx = cnt > 0u ? cnt : 1u;
}
DI void xcd_barrier(const XcdBarrier& b) {
  asm volatile("s_waitcnt vmcnt(0)" ::: "memory");
  __syncthreads();
  if (threadIdx.x == 0) {
    unsigned* bar = b.bar;
    __builtin_amdgcn_s_waitcnt(0);
    unsigned nloc = b.st[0], nx = b.st[1];
    if (nloc == 0u) { xcd_barrier_complete(bar, b.x, nloc, nx); b.st[0] = nloc; b.st[1] = nx; }
    const unsigned old = xb_add(&bar[XB_XSUB(b.x)], 1u);
    const unsigned gen = old / nloc;
    if (old + 1u == (gen + 1u) * nloc) {
      __builtin_amdgcn_fence(__ATOMIC_RELEASE, "agent");
      asm volatile("s_waitcnt vmcnt(0)" ::: "memory");
      const unsigned og = xb_add(&bar[XB_TOP], 1u);
      const unsigned tg = og / nx;
      if (og + 1u == (tg + 1u) * nx) xb_add(&bar[XB_TOPGEN], 1u);
      else XB_SPIN(xb_ld(&bar[XB_TOPGEN]) == tg, bar);
      __builtin_amdgcn_fence(__ATOMIC_ACQUIRE, "agent");
      xb_add(&bar[XB_XGEN(b.x)], 1u);
      asm volatile("s_waitcnt vmcnt(0)" ::: "memory");
    } else {
      XB_SPIN(xb_ld(&bar[XB_XGEN(b.x)]) == gen, bar);
      __builtin_amdgcn_fence(__ATOMIC_ACQUIRE, "agent");
      asm volatile("s_waitcnt vmcnt(0)" ::: "memory");
    }
  }
  __syncthreads();
}

constexpr int SMEM_MAIN = 65536;
constexpr int SMEM_AGG = 2048;
constexpr int SMEM_BYTES = SMEM_MAIN + SMEM_AGG + 16;

DI void transpose_tile(const float* src, int ldsrc, int ncols_valid, const float* gscale, bf16_t* dst, int lddst,
                       int k0, int n0, char* smem) {
  float* tile = (float*)smem;
  const int tid = threadIdx.x, tx = tid & 63, ty = tid >> 6;
  __syncthreads();
#pragma unroll 4
  for (int i = 0; i < 16; ++i) {
    int k = ty * 16 + i;
    float v = (n0 + tx < ncols_valid) ? src[(size_t)(k0 + k) * ldsrc + n0 + tx] : 0.f;
    tile[k * 65 + tx] = v;
  }
  __syncthreads();
  float g = gscale ? gscale[k0 + tx] : 1.f;
#pragma unroll 4
  for (int i = 0; i < 16; ++i) {
    int n = ty * 16 + i;
    dst[(size_t)(n0 + n) * lddst + k0 + tx] = f2bf(tile[tx * 65 + n] * g);
  }
}

DI void phase_prep(const Params& p, char* smem) {
  char* ws = p.ws;
  const int tid = threadIdx.x, lane = tid & 63, wid = tid >> 6;
  constexpr int N_WINA = 16 * 28, N_WUQ = 6 * 24, N_WUKV = 4 * 32, N_WOUTA = 256, N_WINB = 16 * 32, N_WRG = 64, N_WIG = 64, N_WOUTB = 256;
  constexpr int T0 = N_WINA, T1 = T0 + N_WUQ, T2 = T1 + N_WUKV, T3 = T2 + N_WOUTA, T4 = T3 + N_WINB, T5 = T4 + N_WRG, T6 = T5 + N_WIG, T7 = T6 + N_WOUTB;
  constexpr int N_ROWS = MP / 4;
  constexpr int N_ROPE = TP * 32 / 256;
  constexpr int TOTAL = T7 + N_ROWS + N_ROPE;
  for (int it = blockIdx.x; it < TOTAL; it += gridDim.x) {
    if (it < T7) {
      if (it < T0)      { int t = it;      transpose_tile(p.a_w_in, 1728, 1728, p.a_norm_g, (bf16_t*)(ws + OFF_WINA), 1024, (t % 16) * 64, (t / 16) * 64, smem); }
      else if (it < T1) { int t = it - T0; transpose_tile(p.a_w_uq, 1536, 1536, p.a_q_norm_g, (bf16_t*)(ws + OFF_WUQ), 384, (t % 6) * 64, (t / 6) * 64, smem); }
      else if (it < T2) { int t = it - T1; transpose_tile(p.a_w_ukv, 2048, 2048, p.a_kv_norm_g, (bf16_t*)(ws + OFF_WUKV), 256, (t % 4) * 64, (t / 4) * 64, smem); }
      else if (it < T3) { int t = it - T2; transpose_tile(p.a_w_out, 1024, 1024, nullptr, (bf16_t*)(ws + OFF_WOUTA), 1024, (t % 16) * 64, (t / 16) * 64, smem); }
      else if (it < T4) { int t = it - T3; transpose_tile(p.b_w_in, 2048, 2048, p.b_norm_g, (bf16_t*)(ws + OFF_WINB), 1024, (t % 16) * 64, (t / 16) * 64, smem); }
      else if (it < T5) { int t = it - T4; int g = t >> 4; t &= 15; transpose_tile(p.b_w_rg + g * 65536, 256, 256, nullptr, (bf16_t*)(ws + OFF_WRG) + g * 65536, 256, (t & 3) * 64, (t >> 2) * 64, smem); }
      else if (it < T6) { int t = it - T5; int g = t >> 4; t &= 15; transpose_tile(p.b_w_ig + g * 65536, 256, 256, nullptr, (bf16_t*)(ws + OFF_WIG) + g * 65536, 256, (t & 3) * 64, (t >> 2) * 64, smem); }
      else              { int t = it - T6; transpose_tile(p.b_w_out, 1024, 1024, nullptr, (bf16_t*)(ws + OFF_WOUTB), 1024, (t % 16) * 64, (t / 16) * 64, smem); }
    } else if (it < T7 + N_ROWS) {
      const int row = (it - T7) * 4 + wid;
      const int b = row / TP, pp = row % TP;
      bf16_t* dst = (bf16_t*)(ws + OFF_XN0) + (size_t)row * DM;
      float* rinv0 = (float*)(ws + OFF_RINV0);
      if (pp < PAD) {
#pragma unroll
        for (int i = 0; i < 4; ++i) *(uint2*)(dst + i * 256 + lane * 4) = make_uint2(0u, 0u);
        if (lane == 0) rinv0[row] = 0.f;
      } else {
        const int pos = pp - PAD;
        const float* src = pos < NMETA ? p.meta + pos * DM : p.x + ((size_t)b * SEQ + (pos - NMETA)) * DM;
        float ss = 0.f;
        float4 v[4];
#pragma unroll
        for (int i = 0; i < 4; ++i) { v[i] = *(const float4*)(src + i * 256 + lane * 4); ss += v[i].x * v[i].x + v[i].y * v[i].y + v[i].z * v[i].z + v[i].w * v[i].w; }
#pragma unroll
        for (int o = 32; o >= 1; o >>= 1) ss += __shfl_xor(ss, o);
#pragma unroll
        for (int i = 0; i < 4; ++i) *(uint2*)(dst + i * 256 + lane * 4) = make_uint2(pack2(v[i].x, v[i].y), pack2(v[i].z, v[i].w));
        if (lane == 0) rinv0[row] = rsqrtf(ss * (1.f / 1024.f) + RMS_EPS);
      }
    } else {
      const int e = (it - T7 - N_ROWS) * 256 + tid;
      const int pp = e >> 5, i = e & 31;
      const float inv_freq = __builtin_amdgcn_exp2f(-(float)i * (13.287712379549449f / 32.f));
      const float ang = (float)(pp - PAD) * inv_freq;
      const double rev = (double)ang * 0.15915494309189535;
      const float fr_ = (float)(rev - rint(rev));
      const float s = __builtin_amdgcn_sinf(fr_), c = __builtin_amdgcn_cosf(fr_);
      ((float*)(ws + OFF_ROPEC))[e] = c;
      ((float*)(ws + OFF_ROPES))[e] = s;
    }
  }
}

enum { M_G1 = 1, M_Q = 2, M_KV = 3, M_OUTA = 4, M_INB = 5, M_RG = 6, M_OUTB = 7 };

DI void row_ssq_store(const float (&sq)[4][4], float* ssq, int row_base, int slab, int fr, int fq) {
#pragma unroll
  for (int m = 0; m < 4; ++m)
#pragma unroll
    for (int j = 0; j < 4; ++j) {
      float v = sq[m][j];
      v += __shfl_xor(v, 1); v += __shfl_xor(v, 2); v += __shfl_xor(v, 4); v += __shfl_xor(v, 8);
      if (fr == 0) ssq[(size_t)(row_base + m * 16 + fq * 4 + j) * 16 + slab] = v;
    }
}

template <int MODE>
DI void gemm_tile(const Params& p, int mt, int nt, char* smem) {
  char* ws = p.ws;
  const int tid = threadIdx.x, lane = tid & 63, wid = tid >> 6;
  const int wr = wid >> 1, wc = wid & 1, fr = lane & 15, fq = lane >> 4;
  const int m0 = mt * 128, n0 = nt * 128;
  const int lrow = tid >> 3, lkc = tid & 7;

  const bf16_t* Ab; int lda; const bf16_t* Bb; int ldb; int nk;
  if constexpr (MODE == M_G1)   { Ab = (const bf16_t*)(ws + OFF_XN0); lda = 1024; Bb = (const bf16_t*)(ws + OFF_WINA); ldb = 1024; nk = 16; }
  if constexpr (MODE == M_Q)    { Ab = (const bf16_t*)(ws + OFF_QLAT); lda = 640; Bb = (const bf16_t*)(ws + OFF_WUQ); ldb = 384; nk = 6; }
  if constexpr (MODE == M_KV)   { Ab = (const bf16_t*)(ws + OFF_QLAT) + 384; lda = 640; Bb = (const bf16_t*)(ws + OFF_WUKV); ldb = 256; nk = 4; }
  if constexpr (MODE == M_OUTA) { Ab = (const bf16_t*)(ws + OFF_Y); lda = 1024; Bb = (const bf16_t*)(ws + OFF_WOUTA); ldb = 1024; nk = 16; }
  if constexpr (MODE == M_INB)  { Ab = (const bf16_t*)(ws + OFF_H1B); lda = 1024; Bb = (const bf16_t*)(ws + OFF_WINB); ldb = 1024; nk = 16; }
  if constexpr (MODE == M_OUTB) { Ab = (const bf16_t*)(ws + OFF_HSL); lda = 1024; Bb = (const bf16_t*)(ws + OFF_WOUTB); ldb = 1024; nk = 16; }
  if constexpr (MODE == M_RG)   { Ab = (const bf16_t*)(ws + OFF_U); lda = 1024; Bb = nullptr; ldb = 256; nk = 4; }
  const int rg_g = nt >> 2, rg_sc = nt & 3;

  const bf16_t* Ap = Ab + (size_t)(m0 + lrow) * lda + lkc * 8;
  const bf16_t* Bp = nullptr;
  if constexpr (MODE != M_RG) Bp = Bb + (size_t)(n0 + lrow) * ldb + lkc * 8;

  f32x4 acc[4][4];
#pragma unroll
  for (int m = 0; m < 4; ++m)
#pragma unroll
    for (int n = 0; n < 4; ++n) acc[m][n] = f32x4{0.f, 0.f, 0.f, 0.f};

  uint4 ra[4], rb[4];

  auto issue_loads = [&](int kt) __attribute__((always_inline)) {
    if constexpr (MODE != M_RG) {
#pragma unroll
      for (int i = 0; i < 4; ++i) ra[i] = *(const uint4*)(Ap + (size_t)(32 * i) * lda + kt * 64);
#pragma unroll
      for (int i = 0; i < 4; ++i) rb[i] = *(const uint4*)(Bp + (size_t)(32 * i) * ldb + kt * 64);
    } else {
      const int kc = (rg_sc + 1 + kt) & 3;
#pragma unroll
      for (int i = 0; i < 4; ++i) {
        const bf16_t* W = (const bf16_t*)(ws + ((i & 1) ? OFF_WIG : OFF_WRG));
        const int chl = lrow + 32 * (i >> 1);
        rb[i] = *(const uint4*)(W + (size_t)(rg_g * 256 + rg_sc * 64 + chl) * 256 + kc * 64 + lkc * 8);
      }
    }
  };
  auto commit = [&](int kt) __attribute__((always_inline)) {
    char* As = smem + (kt & 1) * 32768;
    char* Bs = As + 16384;
    if constexpr (MODE != M_RG) {
#pragma unroll
      for (int i = 0; i < 4; ++i) *(uint4*)(As + st_off(lrow + 32 * i, lkc)) = ra[i];
    } else {
      const int kc = (rg_sc + 1 + kt) & 3;
      const int ch0 = rg_g * 256 + kc * 64 + lkc * 8;
      const int r0 = lrow * 4;
      u32x4 ur[7];
#pragma unroll
      for (int q = 0; q < 7; ++q) {
        int rr = m0 + r0 - 3 + q; rr = rr < 0 ? 0 : rr;
        ur[q] = *(const u32x4*)(Ab + (size_t)rr * 1024 + ch0);
      }
      unsigned res[4][4];
#pragma unroll
      for (int cp = 0; cp < 4; ++cp) {
        const float2 bia = *(const float2*)(p.b_conv_b + ch0 + 2 * cp);
        float o0[4], o1[4];
#pragma unroll
        for (int t = 0; t < 4; ++t) { o0[t] = bia.x; o1[t] = bia.y; }
#pragma unroll
        for (int j = 0; j < 4; ++j) {
          const float2 w = *(const float2*)(p.b_conv_w + j * 1024 + ch0 + 2 * cp);
#pragma unroll
          for (int t = 0; t < 4; ++t) {
            const unsigned uu = ur[t + j][cp];
            o0[t] += w.x * bflo(uu); o1[t] += w.y * bfhi(uu);
          }
        }
#pragma unroll
        for (int t = 0; t < 4; ++t) res[t][cp] = pack2(o0[t], o1[t]);
      }
#pragma unroll
      for (int t = 0; t < 4; ++t) *(uint4*)(As + st_off(r0 + t, lkc)) = make_uint4(res[t][0], res[t][1], res[t][2], res[t][3]);
    }
#pragma unroll
    for (int i = 0; i < 4; ++i) *(uint4*)(Bs + st_off(lrow + 32 * i, lkc)) = rb[i];
  };

  __syncthreads();
  issue_loads(0);
  commit(0);
  __syncthreads();
  for (int kt = 0; kt < nk; ++kt) {
    if (kt + 1 < nk) issue_loads(kt + 1);
    {
      const char* As = smem + (kt & 1) * 32768;
      const char* Bs = As + 16384;
#pragma unroll
      for (int kk = 0; kk < 2; ++kk) {
        bf16x8 af[4], bfr[4];
#pragma unroll
        for (int m = 0; m < 4; ++m) af[m] = *(const bf16x8*)(As + st_off(wr * 64 + m * 16 + fr, kk * 4 + fq));
#pragma unroll
        for (int n = 0; n < 4; ++n) bfr[n] = *(const bf16x8*)(Bs + st_off(wc * 64 + n * 16 + fr, kk * 4 + fq));
#pragma unroll
        for (int m = 0; m < 4; ++m)
#pragma unroll
          for (int n = 0; n < 4; ++n) acc[m][n] = mfma16(af[m], bfr[n], acc[m][n]);
      }
    }
    if (kt + 1 < nk) commit(kt + 1);
    __syncthreads();
  }

  const int rbase = m0 + wr * 64;
  const int bidx = m0 / TP;
  const int ppbase = (m0 % TP) + wr * 64;
  const int slab = (n0 + wc * 64) >> 6;

  if constexpr (MODE == M_G1) {
    const float* rinv0 = (const float*)(ws + OFF_RINV0);
    float rs[4][4];
#pragma unroll
    for (int m = 0; m < 4; ++m)
#pragma unroll
      for (int j = 0; j < 4; ++j) rs[m][j] = rinv0[rbase + m * 16 + fq * 4 + j];
    if (slab < 10) {
      bf16_t* ql = (bf16_t*)(ws + OFF_QLAT);
      float sq[4][4];
#pragma unroll
      for (int m = 0; m < 4; ++m)
#pragma unroll
        for (int j = 0; j < 4; ++j) {
          float s = 0.f;
#pragma unroll
          for (int n = 0; n < 4; ++n) {
            float v = acc[m][n][j] * rs[m][j];
            s += v * v;
            ql[(size_t)(rbase + m * 16 + fq * 4 + j) * 640 + slab * 64 + n * 16 + fr] = f2bf(v);
          }
          sq[m][j] = s;
        }
      row_ssq_store(sq, (float*)(ws + OFF_SSQA), rbase, slab, fr, fq);
    } else if (slab == 10) {
      bf16_t* kr = (bf16_t*)(ws + OFF_KROPE);
      const float* rc = (const float*)(ws + OFF_ROPEC); const float* rsn = (const float*)(ws + OFF_ROPES);
#pragma unroll
      for (int m = 0; m < 4; ++m)
#pragma unroll
        for (int j = 0; j < 4; ++j) {
          const int row = rbase + m * 16 + fq * 4 + j, pp = ppbase + m * 16 + fq * 4 + j;
#pragma unroll
          for (int n = 0; n < 2; ++n) {
            const int i = n * 16 + fr;
            const float c = rc[pp * 32 + i], s = rsn[pp * 32 + i];
            const float x1 = acc[m][n][j] * rs[m][j], x2 = acc[m][n + 2][j] * rs[m][j];
            kr[(size_t)row * 64 + i] = f2bf(x1 * c - x2 * s);
            kr[(size_t)row * 64 + 32 + i] = f2bf(x1 * s + x2 * c);
          }
        }
    } else if (slab < 27) {
      bf16_t* ga = (bf16_t*)(ws + OFF_GATEA);
#pragma unroll
      for (int m = 0; m < 4; ++m)
#pragma unroll
        for (int j = 0; j < 4; ++j)
#pragma unroll
          for (int n = 0; n < 4; ++n) {
            float v = acc[m][n][j] * rs[m][j];
            ga[(size_t)(rbase + m * 16 + fq * 4 + j) * 1024 + (slab - 11) * 64 + n * 16 + fr] = f2bf(silu_f(v));
          }
    }
  }

  if constexpr (MODE == M_Q) {
    const float* ssqa = (const float*)(ws + OFF_SSQA);
    const float* rc = (const float*)(ws + OFF_ROPEC); const float* rsn = (const float*)(ws + OFF_ROPES);
    bf16_t* Q = (bf16_t*)(ws + OFF_Q);
    const int head = slab / 3, part = slab % 3;
#pragma unroll
    for (int m = 0; m < 4; ++m)
#pragma unroll
      for (int j = 0; j < 4; ++j) {
        const int row = rbase + m * 16 + fq * 4 + j, pp = ppbase + m * 16 + fq * 4 + j;
        const float* sp = ssqa + (size_t)row * 16;
        const float ss = sp[0] + sp[1] + sp[2] + sp[3] + sp[4] + sp[5];
        const float sc = rsqrtf(ss * (1.f / 384.f) + RMS_EPS) * QSCALE;
        bf16_t* qrow = Q + ((size_t)(bidx * 8 + head) * TP + pp) * 192;
        if (part < 2) {
#pragma unroll
          for (int n = 0; n < 4; ++n) qrow[part * 64 + n * 16 + fr] = f2bf(acc[m][n][j] * sc);
        } else {
#pragma unroll
          for (int n = 0; n < 2; ++n) {
            const int i = n * 16 + fr;
            const float c = rc[pp * 32 + i], s = rsn[pp * 32 + i];
            const float x1 = acc[m][n][j] * sc, x2 = acc[m][n + 2][j] * sc;
            qrow[128 + i] = f2bf(x1 * c - x2 * s);
            qrow[160 + i] = f2bf(x1 * s + x2 * c);
          }
        }
      }
  }

  if constexpr (MODE == M_KV) {
    const float* ssqa = (const float*)(ws + OFF_SSQA);
    const int head = nt >> 1, isv = nt & 1;
#pragma unroll
    for (int m = 0; m < 4; ++m) {
      float sc[4];
#pragma unroll
      for (int j = 0; j < 4; ++j) {
        const float* sp = ssqa + (size_t)(rbase + m * 16 + fq * 4 + j) * 16;
        sc[j] = rsqrtf((sp[6] + sp[7] + sp[8] + sp[9]) * (1.f / 256.f) + RMS_EPS);
      }
      const int pp = ppbase + m * 16 + fq * 4;
      if (!isv) {
        bf16_t* KN = (bf16_t*)(ws + OFF_KN) + ((size_t)(bidx * 8 + head) * TP + pp) * 128;
#pragma unroll
        for (int j = 0; j < 4; ++j)
#pragma unroll
          for (int n = 0; n < 4; ++n) KN[(size_t)j * 128 + wc * 64 + n * 16 + fr] = f2bf(acc[m][n][j] * sc[j]);
      } else {
        bf16_t* VT = (bf16_t*)(ws + OFF_VT) + (size_t)(bidx * 8 + head) * 128 * TP + pp;
#pragma unroll
        for (int n = 0; n < 4; ++n) {
          const int c = wc * 64 + n * 16 + fr;
          *(uint2*)(VT + (size_t)c * TP) = make_uint2(pack2(acc[m][n][0] * sc[0], acc[m][n][1] * sc[1]), pack2(acc[m][n][2] * sc[2], acc[m][n][3] * sc[3]));
        }
      }
    }
  }

  if constexpr (MODE == M_OUTA) {
    float* H1 = (float*)(ws + OFF_H1);
    bf16_t* H1B = (bf16_t*)(ws + OFF_H1B);
    float sq[4][4];
#pragma unroll
    for (int m = 0; m < 4; ++m)
#pragma unroll
      for (int j = 0; j < 4; ++j) {
        const int row = rbase + m * 16 + fq * 4 + j, pp = ppbase + m * 16 + fq * 4 + j;
        float s = 0.f;
#pragma unroll
        for (int n = 0; n < 4; ++n) {
          const int col = n0 + wc * 64 + n * 16 + fr;
          const float v = acc[m][n][j] + h0_val(p, bidx, pp, col);
          H1[(size_t)row * 1024 + col] = v;
          H1B[(size_t)row * 1024 + col] = f2bf(v);
          s += v * v;
        }
        sq[m][j] = s;
      }
    row_ssq_store(sq, (float*)(ws + OFF_SSQ1), rbase, slab, fr, fq);
  }

  if constexpr (MODE == M_INB) {
    const float* ssq1 = (const float*)(ws + OFF_SSQ1);
    bf16_t* dstb = (bf16_t*)(ws + (nt < 8 ? OFF_U : OFF_GATEB));
    const int cbase = (nt & 7) * 128 + wc * 64;
#pragma unroll
    for (int m = 0; m < 4; ++m)
#pragma unroll
      for (int j = 0; j < 4; ++j) {
        const int row = rbase + m * 16 + fq * 4 + j;
        const float4* sp = (const float4*)(ssq1 + (size_t)row * 16);
        const float4 a = sp[0], b = sp[1], c = sp[2], d = sp[3];
        const float ss = (a.x + a.y + a.z + a.w) + (b.x + b.y + b.z + b.w) + (c.x + c.y + c.z + c.w) + (d.x + d.y + d.z + d.w);
        const float sc = rsqrtf(ss * (1.f / 1024.f) + RMS_EPS);
#pragma unroll
        for (int n = 0; n < 4; ++n) {
          float v = acc[m][n][j] * sc;
          if (nt >= 8) v = silu_f(v);
          dstb[(size_t)row * 1024 + cbase + n * 16 + fr] = f2bf(v);
        }
      }
  }

  if constexpr (MODE == M_OUTB) {
    float* H1 = (float*)(ws + OFF_H1);
    float sq[4][4];
#pragma unroll
    for (int m = 0; m < 4; ++m)
#pragma unroll
      for (int j = 0; j < 4; ++j) {
        const int row = rbase + m * 16 + fq * 4 + j;
        float s = 0.f;
#pragma unroll
        for (int n = 0; n < 4; ++n) {
          const int col = n0 + wc * 64 + n * 16 + fr;
          const float v = acc[m][n][j] + H1[(size_t)row * 1024 + col];
          H1[(size_t)row * 1024 + col] = v;
          s += v * v;
        }
        sq[m][j] = s;
      }
    row_ssq_store(sq, (float*)(ws + OFF_SSQ2), rbase, slab, fr, fq);
  }

  if constexpr (MODE == M_RG) {
    const char* Auc = smem + 32768;
    float uc[4][2][4];
#pragma unroll
    for (int n = 0; n < 2; ++n)
#pragma unroll
      for (int j = 0; j < 4; ++j) {
        const int c = wc * 32 + n * 16 + fr;
        const int ub = (wr * 64 + fq * 4 + j) * 128 + (((c >> 3) ^ ((fq & 1) * 4 + j)) << 4) + (c & 7) * 2;
#pragma unroll
        for (int m = 0; m < 4; ++m) uc[m][n][j] = bf2f(*(const bf16_t*)(Auc + ub + m * 2048));
      }
    __syncthreads();
    float* SA = (float*)smem;
    float* SB = (float*)(smem + 32768);
    float* AGG = (float*)(smem + SMEM_MAIN);
    const int chg = rg_g * 256 + rg_sc * 64;
#pragma unroll
    for (int n = 0; n < 2; ++n) {
      const int c = wc * 32 + n * 16 + fr, ch = chg + c;
      const float brg = p.b_b_rg[ch], big = p.b_b_ig[ch];
      const int sbase = (wr * 64 + fq * 4) * 64 + (c ^ (fq << 4));
#pragma unroll
      for (int m = 0; m < 4; ++m)
#pragma unroll
        for (int j = 0; j < 4; ++j) {
          SA[sbase + (m * 16 + j) * 64] = acc[m][n][j] + brg;
          SB[sbase + (m * 16 + j) * 64] = sigmoid_f(acc[m][n + 2][j] + big) * uc[m][n][j];
        }
    }
    __syncthreads();
    {
      const int c = tid & 63, q = tid >> 6;
      float spl8;
      { const float lam = p.b_lam[chg + c]; const float z = __expf(-lam);
        const float sp = lam < -20.f ? -lam : (z < 1e-2f ? z * (1.f - z * (0.5f - z * (1.f / 3.f))) : __logf(1.f + z));
        spl8 = -8.f * sp; }
      const int ppt = (m0 % TP);
      float P = 1.f, h = 0.f;
#pragma unroll 1
      for (int t = q * 32; t < q * 32 + 32; ++t) {
        const int idx = t * 64 + (c ^ (((t >> 2) & 3) << 4));
        const float r = sigmoid_f(SA[idx]);
        const float log_a = spl8 * r;
        const float em = log_a > -0.25f ? log_a * (1.f + log_a * (0.5f + log_a * ((1.f / 6.f) + log_a * ((1.f / 24.f) + log_a * ((1.f / 120.f) + log_a * (1.f / 720.f))))))
                                         : __expf(log_a) - 1.f;
        float a = 1.f + em;
        float mult = sqrtf(fmaxf(-em * (2.f + em), 0.f));
        const int pp = ppt + t;
        if (pp == PAD) mult = 1.f;
        float bb = mult * SB[idx];
        if (pp < PAD) { a = 1.f; bb = 0.f; }
        h = a * h + bb; P = a * P;
        SA[idx] = P; SB[idx] = h;
      }
      AGG[q * 64 + c] = P; AGG[256 + q * 64 + c] = h;
      __syncthreads();
      float cin = 0.f, Ppre = 1.f;
      for (int qq = 0; qq < q; ++qq) { const float Pq = AGG[qq * 64 + c], hq = AGG[256 + qq * 64 + c]; cin = Pq * cin + hq; Ppre *= Pq; }
      if (q == 3) {
        const float At = Ppre * P, Bt = P * cin + h;
        const int j = (m0 % TP) >> 7;
        ((float*)(ws + OFF_CARA))[((size_t)bidx * NTB + j) * 1024 + chg + c] = At;
        ((float*)(ws + OFF_CARB))[((size_t)bidx * NTB + j) * 1024 + chg + c] = Bt;
      }
      bf16_t* HSL = (bf16_t*)(ws + OFF_HSL); bf16_t* PC = (bf16_t*)(ws + OFF_PCUM);
#pragma unroll 1
      for (int t = q * 32; t < q * 32 + 32; ++t) {
        const int idx = t * 64 + (c ^ (((t >> 2) & 3) << 4));
        const float Pl = SA[idx], hl = SB[idx];
        HSL[(size_t)(m0 + t) * 1024 + chg + c] = f2bf(hl + Pl * cin);
        PC[(size_t)(m0 + t) * 1024 + chg + c] = f2bf(Pl * Ppre);
      }
    }
  }
}

template <int MODE>
DI void gemm_phase(const Params& p, int ntn, char* smem) {
  const int total = NMT * ntn;
  for (int t = blockIdx.x; t < total; t += gridDim.x) {
    gemm_tile<MODE>(p, t / ntn, t % ntn, smem);
  }
}

DI void phase_qkv(const Params& p, char* smem) {
  const int total = NMT * 28;
  for (int t = blockIdx.x; t < total; t += gridDim.x) {
    const int mt = t / 28, n = t % 28;
    if (n < 12) gemm_tile<M_Q>(p, mt, n, smem); else gemm_tile<M_KV>(p, mt, n - 12, smem);
  }
}

DI int koff(int key, int ch) { return key * 384 + (((ch & ~7) | ((ch ^ (key >> 1)) & 7)) << 4); }
DI int voff(int dv, int ch) { return dv * 128 + ((ch ^ ((dv >> 1) & 7)) << 4); }

DI void attn_item(const Params& p, int b, int h, int qt, char* smem) {
  char* ws = p.ws;
  const int tid = threadIdx.x, lane = tid & 63, w = tid >> 6;
  const int r = lane & 31, hh = lane >> 5;
  const int q_pp = qt * 128 + w * 32 + r;
  const int bh = b * 8 + h;
  bf16x8 qf[12];
  {
    const bf16_t* Qp = (const bf16_t*)(ws + OFF_Q) + ((size_t)bh * TP + q_pp) * 192 + hh * 8;
#pragma unroll
    for (int ks = 0; ks < 12; ++ks) qf[ks] = *(const bf16x8*)(Qp + ks * 16);
  }
  f32x16 o[4];
#pragma unroll
  for (int d = 0; d < 4; ++d)
#pragma unroll
    for (int i = 0; i < 16; ++i) o[d][i] = 0.f;
  float m_i = -INFINITY, l_i = 0.f;
  char* Ks = smem; char* Vs = smem + 24576;
  const bf16_t* KNb = (const bf16_t*)(ws + OFF_KN) + (size_t)bh * TP * 128;
  const bf16_t* KRb = (const bf16_t*)(ws + OFF_KROPE) + (size_t)b * TP * 64;
  const bf16_t* VTb = (const bf16_t*)(ws + OFF_VT) + (size_t)bh * 128 * TP;
  const int pir = (r & 19) | ((r & 4) << 1) | ((r & 8) >> 1);
  const int nlast = 2 * qt + 1;
  for (int kt = 1; kt <= nlast; ++kt) {
    __syncthreads();
    {
      uint4 t[10];
#pragma unroll
      for (int i = 0; i < 4; ++i) { const int c = tid + 256 * i, key = c >> 4, ch = c & 15; t[i] = *(const uint4*)(KNb + (size_t)(kt * 64 + key) * 128 + ch * 8); }
#pragma unroll
      for (int i = 0; i < 2; ++i) { const int c = tid + 256 * i, key = c >> 3, ch = c & 7; t[4 + i] = *(const uint4*)(KRb + (size_t)(kt * 64 + key) * 64 + ch * 8); }
#pragma unroll
      for (int i = 0; i < 4; ++i) { const int c = tid + 256 * i, dv = c >> 3, ch = c & 7; t[6 + i] = *(const uint4*)(VTb + (size_t)dv * TP + kt * 64 + ch * 8); }
#pragma unroll
      for (int i = 0; i < 4; ++i) { const int c = tid + 256 * i, key = c >> 4, ch = c & 15; *(uint4*)(Ks + koff(key, ch)) = t[i]; }
#pragma unroll
      for (int i = 0; i < 2; ++i) { const int c = tid + 256 * i, key = c >> 3, ch = 16 + (c & 7); *(uint4*)(Ks + koff(key, ch)) = t[4 + i]; }
#pragma unroll
      for (int i = 0; i < 4; ++i) { const int c = tid + 256 * i, dv = c >> 3, ch = c & 7; *(uint4*)(Vs + voff(dv, ch)) = t[6 + i]; }
    }
    __syncthreads();
    const int kmin = kt * 64;
    const int wq0 = qt * 128 + w * 32;
    if (kmin > wq0 + 31) continue;
    f32x16 s0, s1;
#pragma unroll
    for (int i = 0; i < 16; ++i) { s0[i] = 0.f; s1[i] = 0.f; }
#pragma unroll
    for (int ks = 0; ks < 12; ++ks) {
      const bf16x8 a0 = *(const bf16x8*)(Ks + koff(pir, ks * 2 + hh));
      const bf16x8 a1 = *(const bf16x8*)(Ks + koff(32 + pir, ks * 2 + hh));
      s0 = mfma32(a0, qf[ks], s0);
      s1 = mfma32(a1, qf[ks], s1);
    }
    if (kt == 1 || kmin + 63 > wq0) {
#pragma unroll
      for (int i = 0; i < 16; ++i) {
        const int kl = (i & 3) + 4 * ((i >> 2) & 1) + 8 * hh + 16 * ((i >> 3) & 1);
        const int k0 = kmin + kl, k1 = kmin + 32 + kl;
        if (!(k0 <= q_pp && k0 >= PAD)) s0[i] = -1e30f;
        if (!(k1 <= q_pp && k1 >= PAD)) s1[i] = -1e30f;
      }
    }
    float mx = s0[0];
#pragma unroll
    for (int i = 1; i < 16; ++i) mx = fmaxf(mx, s0[i]);
#pragma unroll
    for (int i = 0; i < 16; ++i) mx = fmaxf(mx, s1[i]);
    mx = fmaxf(mx, __shfl_xor(mx, 32));
    const float m_new = fmaxf(m_i, mx);
    const float alpha = __builtin_amdgcn_exp2f(m_i - m_new);
    m_i = m_new;
    float rsum = 0.f;
#pragma unroll
    for (int i = 0; i < 16; ++i) { s0[i] = __builtin_amdgcn_exp2f(s0[i] - m_new); rsum += s0[i]; }
#pragma unroll
    for (int i = 0; i < 16; ++i) { s1[i] = __builtin_amdgcn_exp2f(s1[i] - m_new); rsum += s1[i]; }
    l_i = l_i * alpha + rsum;
#pragma unroll
    for (int d = 0; d < 4; ++d)
#pragma unroll
      for (int i = 0; i < 16; ++i) o[d][i] *= alpha;
#pragma unroll
    for (int t2 = 0; t2 < 2; ++t2)
#pragma unroll
      for (int sp = 0; sp < 2; ++sp) {
        const f32x16& sx = t2 ? s1 : s0;
        const uint4 pk = make_uint4(pack2(sx[8 * sp + 0], sx[8 * sp + 1]), pack2(sx[8 * sp + 2], sx[8 * sp + 3]),
                                    pack2(sx[8 * sp + 4], sx[8 * sp + 5]), pack2(sx[8 * sp + 6], sx[8 * sp + 7]));
        const bf16x8 pf = __builtin_bit_cast(bf16x8, pk);
        const int ch = (2 * t2 + sp) * 2 + hh;
#pragma unroll
        for (int d = 0; d < 4; ++d) {
          const bf16x8 vf = *(const bf16x8*)(Vs + voff(d * 32 + r, ch));
          o[d] = mfma32(vf, pf, o[d]);
        }
      }
  }
  const float ltot = l_i + __shfl_xor(l_i, 32);
  const float inv = 1.f / ltot;
  const size_t row = (size_t)b * TP + q_pp;
  const bf16_t* ga = (const bf16_t*)(ws + OFF_GATEA) + row * 1024 + h * 128;
  bf16_t* y = (bf16_t*)(ws + OFF_Y) + row * 1024 + h * 128;
#pragma unroll
  for (int d = 0; d < 4; ++d)
#pragma unroll
    for (int g4 = 0; g4 < 4; ++g4) {
      const int dv0 = d * 32 + 8 * g4 + 4 * hh;
      const uint2 gv = *(const uint2*)(ga + dv0);
      const float y0 = o[d][4 * g4 + 0] * inv * bflo(gv.x), y1 = o[d][4 * g4 + 1] * inv * bfhi(gv.x);
      const float y2 = o[d][4 * g4 + 2] * inv * bflo(gv.y), y3 = o[d][4 * g4 + 3] * inv * bfhi(gv.y);
      *(uint2*)(y + dv0) = make_uint2(pack2(y0, y1), pack2(y2, y3));
    }
}

DI void phase_attn(const Params& p, char* smem) {
  constexpr int total = NB * 8 * NTB;
  for (int it = blockIdx.x; it < total; it += gridDim.x) {
    const int qt = NTB - 1 - it / 64, bh = it % 64;
    attn_item(p, bh >> 3, bh & 7, qt, smem);
  }
}

DI void phase_rg2(const Params& p) {
  char* ws = p.ws;
  const int gt = blockIdx.x * 256 + threadIdx.x;
  if (gt < NB * 1024) {
    const int b = gt >> 10, ch = gt & 1023;
    const float* CA = (const float*)(ws + OFF_CARA) + (size_t)b * NTB * 1024 + ch;
    const float* CB = (const float*)(ws + OFF_CARB) + (size_t)b * NTB * 1024 + ch;
    float* CI = (float*)(ws + OFF_CARIN) + (size_t)b * NTB * 1024 + ch;
    float c = 0.f;
    for (int j = 0; j < NTB; ++j) { CI[j * 1024] = c; c = CA[j * 1024] * c + CB[j * 1024]; }
  }
}

DI void phase_rg3(const Params& p) {
  char* ws = p.ws;
  const size_t total = (size_t)MP * 128;
  bf16_t* HSL = (bf16_t*)(ws + OFF_HSL);
  const bf16_t* PC = (const bf16_t*)(ws + OFF_PCUM);
  const bf16_t* GB = (const bf16_t*)(ws + OFF_GATEB);
  const float* CI = (const float*)(ws + OFF_CARIN);
  for (size_t e = (size_t)blockIdx.x * 256 + threadIdx.x; e < total; e += (size_t)gridDim.x * 256) {
    const int row = (int)(e >> 7), c8 = (int)(e & 127) * 8;
    const int b = row / TP, j = (row % TP) >> 7;
    const uint4 hv = *(const uint4*)(HSL + (size_t)row * 1024 + c8);
    const uint4 pv = *(const uint4*)(PC + (size_t)row * 1024 + c8);
    const uint4 gv = *(const uint4*)(GB + (size_t)row * 1024 + c8);
    const float4 c0 = *(const float4*)(CI + ((size_t)b * NTB + j) * 1024 + c8), c1 = *(const float4*)(CI + ((size_t)b * NTB + j) * 1024 + c8 + 4);
    uint4 ov;
    ov.x = pack2((bflo(hv.x) + bflo(pv.x) * c0.x) * bflo(gv.x), (bfhi(hv.x) + bfhi(pv.x) * c0.y) * bfhi(gv.x));
    ov.y = pack2((bflo(hv.y) + bflo(pv.y) * c0.z) * bflo(gv.y), (bfhi(hv.y) + bfhi(pv.y) * c0.w) * bfhi(gv.y));
    ov.z = pack2((bflo(hv.z) + bflo(pv.z) * c1.x) * bflo(gv.z), (bfhi(hv.z) + bfhi(pv.z) * c1.y) * bfhi(gv.z));
    ov.w = pack2((bflo(hv.w) + bflo(pv.w) * c1.z) * bflo(gv.w), (bfhi(hv.w) + bfhi(pv.w) * c1.w) * bfhi(gv.w));
    *(uint4*)(HSL + (size_t)row * 1024 + c8) = ov;
  }
}

DI void phase_final(const Params& p) {
  char* ws = p.ws;
  const int lane = threadIdx.x & 63, wid = threadIdx.x >> 6;
  const float* H = (const float*)(ws + OFF_H1);
  const float* ssq2 = (const float*)(ws + OFF_SSQ2);
  for (int it = blockIdx.x; it < NB * SEQ / 4; it += gridDim.x) {
    const int orow = it * 4 + wid;
    const int b = orow >> 12, s = orow & 4095;
    const int row = b * TP + PAD + NMETA + s;
    float ss = 0.f;
    { const float v = (lane < 16) ? ssq2[(size_t)row * 16 + lane] : 0.f; ss = v; }
#pragma unroll
    for (int o = 8; o >= 1; o >>= 1) ss += __shfl_xor(ss, o);
    ss = __shfl(ss, 0);
    const float sc = rsqrtf(ss * (1.f / 1024.f) + RMS_EPS);
#pragma unroll
    for (int i = 0; i < 4; ++i) {
      const int col = i * 256 + lane * 4;
      const float4 v = *(const float4*)(H + (size_t)row * 1024 + col);
      const float4 g = *(const float4*)(p.final_norm_g + col);
      *(float4*)(p.out + (size_t)orow * 1024 + col) = make_float4(v.x * sc * g.x, v.y * sc * g.y, v.z * sc * g.z, v.w * sc * g.w);
    }
  }
}

constexpr int N_PHASES = 11;

__global__ void __launch_bounds__(256, 2) fwd_mega(Params p, int ph_lo, int ph_hi, int coop) {
  __shared__ __attribute__((aligned(16))) char smem[SMEM_BYTES];
  XcdBarrier xb;
  if (coop) {
    if (threadIdx.x < 4) { ((volatile unsigned*)(smem + SMEM_MAIN + SMEM_AGG))[threadIdx.x] = 0u; }
    __syncthreads();
    xb = xcd_barrier_post((unsigned*)(p.ws + OFF_BAR), (volatile LAS unsigned*)(smem + SMEM_MAIN + SMEM_AGG));
    if (coop == 2) cg::this_grid().sync();
  }
#ifndef ONLY_PHASE
#define ONLY_PHASE -1
#endif
#define RUN_PHASE(k, call) if ((ONLY_PHASE < 0 || ONLY_PHASE == (k)) && ph_lo <= (k) && (k) < ph_hi) { call; if (coop && (k) + 1 < ph_hi) xcd_barrier(xb); }
  RUN_PHASE(0, phase_prep(p, smem))
  RUN_PHASE(1, gemm_phase<M_G1>(p, 14, smem))
  RUN_PHASE(2, phase_qkv(p, smem))
  RUN_PHASE(3, phase_attn(p, smem))
  RUN_PHASE(4, gemm_phase<M_OUTA>(p, 8, smem))
  RUN_PHASE(5, gemm_phase<M_INB>(p, 16, smem))
  RUN_PHASE(6, gemm_phase<M_RG>(p, 16, smem))
  RUN_PHASE(7, phase_rg2(p))
  RUN_PHASE(8, phase_rg3(p))
  RUN_PHASE(9, gemm_phase<M_OUTB>(p, 8, smem))
  RUN_PHASE(10, phase_final(p))
}

extern "C" void kernel_launch(void* const* d_in, const int* in_sizes, int n_in, void* d_out, int out_size, void* d_ws,
                              size_t ws_size, hipStream_t stream) {
  static int grid_blocks = 0;
  if (!grid_blocks) {
    int dev = 0, cus = 0, per_cu = 0;
    (void)hipGetDevice(&dev);
    (void)hipDeviceGetAttribute(&cus, hipDeviceAttributeMultiprocessorCount, dev);
    (void)hipOccupancyMaxActiveBlocksPerMultiprocessor(&per_cu, fwd_mega, 256, 0);
    if (per_cu > 2) per_cu = 2;
    if (per_cu < 1) per_cu = 1;
    grid_blocks = cus * per_cu;
  }
  if (ws_size < WS_NEEDED) { fprintf(stderr, "workspace too small: %zu < %zu\n", ws_size, (size_t)WS_NEEDED); return; }
  Params p{};
  p.x = (const float*)d_in[0]; p.meta = (const float*)d_in[1];
  p.a_norm_g = (const float*)d_in[2]; p.a_w_in = (const float*)d_in[3]; p.a_q_norm_g = (const float*)d_in[4];
  p.a_kv_norm_g = (const float*)d_in[5]; p.a_w_uq = (const float*)d_in[6]; p.a_w_ukv = (const float*)d_in[7];
  p.a_w_out = (const float*)d_in[8]; p.b_norm_g = (const float*)d_in[9]; p.b_w_in = (const float*)d_in[10];
  p.b_conv_w = (const float*)d_in[11]; p.b_conv_b = (const float*)d_in[12]; p.b_w_rg = (const float*)d_in[13];
  p.b_b_rg = (const float*)d_in[14]; p.b_w_ig = (const float*)d_in[15]; p.b_b_ig = (const float*)d_in[16];
  p.b_lam = (const float*)d_in[17]; p.b_w_out = (const float*)d_in[18]; p.final_norm_g = (const float*)d_in[19];
  p.out = (float*)d_out; p.ws = (char*)d_ws;
#if SINGLE_LAUNCH
  (void)hipMemsetAsync((char*)d_ws + OFF_BAR, 0, XCD_BAR_WORDS * 4, stream);
  int lo = 0, hi = N_PHASES, coop = 1;
  void* args[] = {&p, &lo, &hi, &coop};
  hipError_t e = hipLaunchCooperativeKernel((void*)fwd_mega, dim3(grid_blocks), dim3(256), args, 0, stream);
  if (e != hipSuccess) fprintf(stderr, "cooperative launch failed: %s (grid %d)\n", hipGetErrorString(e), grid_blocks);
#else
  for (int ph = 0; ph < N_PHASES; ++ph) fwd_mega<<<grid_blocks, 256, 0, stream>>>(p, ph, ph + 1, 0);
#endif
}
```

```cpp
#include <hip/hip_runtime.h>
#include <hip/hip_cooperative_groups.h>
#include <cstdio>
#include <cstdint>
namespace cg = cooperative_groups;

#ifndef SINGLE_LAUNCH
#define SINGLE_LAUNCH 1
#endif

#define DI __device__ __forceinline__
typedef unsigned short bf16_t;
using bf16x8 = __attribute__((ext_vector_type(8))) short;
using f32x4  = __attribute__((ext_vector_type(4))) float;
using f32x16 = __attribute__((ext_vector_type(16))) float;
using u32x4 = __attribute__((ext_vector_type(4))) unsigned;
typedef __bf16 bf16v2 __attribute__((ext_vector_type(2)));

constexpr int NB = 8, SEQ = 4096, NMETA = 16;
constexpr int TP = 4224;
constexpr int PAD = 112;
constexpr int MP = NB * TP;
constexpr int NMT = MP / 128;
constexpr int DM = 1024;
constexpr int NTB = TP / 128;
constexpr int NCH = TP / 64;
constexpr float RMS_EPS = 1e-6f;
constexpr float QSCALE = 0.07216878364870322f * 1.4426950408889634f;

constexpr size_t SZ = (size_t)MP * 1024 * 2;
constexpr size_t OFF_XN0 = 0;
constexpr size_t OFF_Y = SZ;
constexpr size_t OFF_U = 0;
constexpr size_t OFF_QLAT = SZ;
constexpr size_t OFF_GATEB = SZ;
constexpr size_t OFF_GATEA = 2 * SZ;
constexpr size_t OFF_H1B = 3 * SZ;
constexpr size_t OFF_HSL = 2 * SZ;
constexpr size_t OFF_Q = 3 * SZ;
constexpr size_t OFF_KN = 4 * SZ + SZ / 2;
constexpr size_t OFF_VT = 5 * SZ + SZ / 2;
constexpr size_t OFF_H1 = 0;
constexpr size_t OFF_UC = 4 * SZ;
constexpr size_t OFF_PCUM = 5 * SZ;
constexpr size_t OFF_MISC = 6 * SZ + SZ / 2;
constexpr size_t OFF_KROPE = OFF_MISC;
constexpr size_t OFF_WINA = OFF_KROPE + (size_t)MP * 64 * 2;
constexpr size_t OFF_WUQ = OFF_WINA + (size_t)1792 * 1024 * 2;
constexpr size_t OFF_WUKV = OFF_WUQ + (size_t)1536 * 384 * 2;
constexpr size_t OFF_WK = OFF_WUKV;
constexpr size_t OFF_WV = OFF_WUKV + (size_t)1024 * 256 * 2;
constexpr size_t OFF_WOUTA = OFF_WUKV + (size_t)2048 * 256 * 2;
constexpr size_t OFF_WINB = OFF_WOUTA + (size_t)1024 * 1024 * 2;
constexpr size_t OFF_WRG = OFF_WINB + (size_t)2048 * 1024 * 2;
constexpr size_t OFF_WIG = OFF_WRG + (size_t)4 * 256 * 256 * 2;
constexpr size_t OFF_WOUTB = OFF_WIG + (size_t)4 * 256 * 256 * 2;
constexpr size_t OFF_RINV0 = OFF_WOUTB + (size_t)1024 * 1024 * 2;
constexpr size_t OFF_SSQA = OFF_RINV0 + (size_t)MP * 4;
constexpr size_t OFF_SSQ1 = OFF_SSQA + (size_t)MP * 32 * 4;
constexpr size_t OFF_SSQ2 = OFF_SSQ1 + (size_t)MP * 32 * 4;
constexpr size_t OFF_ROPEC = OFF_SSQ2 + (size_t)MP * 32 * 4;
constexpr size_t OFF_ROPES = OFF_ROPEC + (size_t)TP * 32 * 4;
constexpr size_t OFF_CARA = OFF_ROPES + (size_t)TP * 32 * 4;
constexpr size_t OFF_CARB = OFF_CARA + (size_t)NB * NCH * 1024 * 4;
constexpr size_t OFF_CARIN = OFF_CARB + (size_t)NB * NCH * 1024 * 4;
constexpr size_t OFF_BAR = OFF_CARIN + (size_t)NB * NCH * 1024 * 4;
constexpr size_t OFF_RDY = OFF_BAR + 16384;
constexpr size_t RDY_BYTES = 2 * 136 * 256;
constexpr size_t WS_NEEDED = OFF_RDY + RDY_BYTES;

struct Params {
  const float* x; const float* meta;
  const float* a_norm_g; const float* a_w_in; const float* a_q_norm_g; const float* a_kv_norm_g;
  const float* a_w_uq; const float* a_w_ukv; const float* a_w_out;
  const float* b_norm_g; const float* b_w_in; const float* b_conv_w; const float* b_conv_b;
  const float* b_w_rg; const float* b_b_rg; const float* b_w_ig; const float* b_b_ig;
  const float* b_lam; const float* b_w_out; const float* final_norm_g;
  float* out; char* ws;
};

DI unsigned pack2(float a, float b) { bf16v2 v = {(__bf16)a, (__bf16)b}; return __builtin_bit_cast(unsigned, v); }
DI bf16_t f2bf(float a) { __bf16 v = (__bf16)a; return __builtin_bit_cast(bf16_t, v); }
DI float bf2f(bf16_t v) { return __uint_as_float(((unsigned)v) << 16); }
DI float bflo(unsigned u) { return __uint_as_float(u << 16); }
DI float bfhi(unsigned u) { return __uint_as_float(u & 0xffff0000u); }
DI float sigmoid_f(float v) { return __builtin_amdgcn_rcpf(1.f + __expf(-v)); }
DI float silu_f(float v) { return v * sigmoid_f(v); }
DI f32x4 mfma16(bf16x8 a, bf16x8 b, f32x4 c) { return __builtin_amdgcn_mfma_f32_16x16x32_bf16(a, b, c, 0, 0, 0); }
DI f32x16 mfma32(bf16x8 a, bf16x8 b, f32x16 c) { return __builtin_amdgcn_mfma_f32_32x32x16_bf16(a, b, c, 0, 0, 0); }

#define XB_TMO      128
#define XB_XCNT(j)  (256  + 64 * (j))
#define XB_XSUB(j)  (1280 + 64 * (j))
#define XB_XGEN(j)  (2304 + 64 * (j))
#define XB_TOP      3328
#define XB_TOPGEN   3392
#define XCD_BAR_WORDS 3456
#define XB_SPIN_CAP (1u << 22)
#define LAS __attribute__((address_space(3)))
DI unsigned xb_ld(unsigned* p)              { return __hip_atomic_load(p, __ATOMIC_RELAXED, __HIP_MEMORY_SCOPE_AGENT); }
DI unsigned xb_add(unsigned* p, unsigned v) { return __hip_atomic_fetch_add(p, v, __ATOMIC_RELAXED, __HIP_MEMORY_SCOPE_AGENT); }
DI unsigned xb_xcc_id() { return (unsigned)__builtin_amdgcn_s_getreg((3 << 11) | 20) & 0xFu; }
#define XB_SPIN(cond, bar) do { unsigned _sp = 0; while (cond) { __builtin_amdgcn_s_sleep(1); \
    if ((++_sp & 255u) == 0u) { if (xb_ld(&(bar)[XB_TMO])) break; if (_sp > XB_SPIN_CAP) { atomicAdd(&(bar)[XB_TMO], 1u); break; } } } } while (0)
struct XcdBarrier { unsigned* bar; unsigned x; volatile LAS unsigned* st; };
DI XcdBarrier xcd_barrier_post(unsigned* bar, volatile LAS unsigned* st) {
  XcdBarrier b; b.bar = bar; b.x = xb_xcc_id(); b.st = st;
  if (threadIdx.x == 0) (void)xb_add(&bar[XB_XCNT(b.x)], 1u);
  return b;
}
DI void xcd_barrier_complete(unsigned* bar, unsigned x, unsigned& nloc, unsigned& nx) {
  const unsigned G = gridDim.x * gridDim.y * gridDim.z;
  unsigned sum, cnt, mine, sp = 0u;
  for (;;) {
    sum = 0u; cnt = 0u; mine = 0u;
#pragma unroll
    for (unsigned j = 0; j < 16; ++j) { const unsigned c = xb_ld(&bar[XB_XCNT(j)]); sum += c; cnt += (c > 0u) ? 1u : 0u; mine = (j == x) ? c : mine; }
    if (sum == G) break;
    __builtin_amdgcn_s_sleep(1);
    if ((++sp & 255u) == 0u) { if (xb_ld(&bar[XB_TMO])) break; if (sp > XB_SPIN_CAP) { atomicAdd(&bar[XB_TMO], 1u); break; } }
  }
  nloc = mine > 0u ? mine : 1u; nx = cnt > 0u ? cnt : 1u;
}
DI void xcd_barrier(const XcdBarrier& b) {
  asm volatile("s_waitcnt vmcnt(0)" ::: "memory");
  __syncthreads();
  if (threadIdx.x == 0) {
    unsigned* bar = b.bar;
    __builtin_amdgcn_s_waitcnt(0);
    unsigned nloc = b.st[0], nx = b.st[1];
    if (nloc == 0u) { xcd_barrier_complete(bar, b.x, nloc, nx); b.st[0] = nloc; b.st[1] = nx; }
    const unsigned old = xb_add(&bar[XB_XSUB(b.x)], 1u);
    const unsigned gen = old / nloc;
    if (old + 1u == (gen + 1u) * nloc) {
      __builtin_amdgcn_fence(__ATOMIC_RELEASE, "agent");
      asm volatile("s_waitcnt vmcnt(0)" ::: "memory");
      const unsigned og = xb_add(&bar[XB_TOP], 1u);
      const unsigned tg = og / nx;
      if (og + 1u == (tg + 1u) * nx) xb_add(&bar[XB_TOPGEN], 1u);
      else XB_SPIN(xb_ld(&bar[XB_TOPGEN]) == tg, bar);
      __builtin_amdgcn_fence(__ATOMIC_ACQUIRE, "agent");
      xb_add(&bar[XB_XGEN(b.x)], 1u);
      asm volatile("s_waitcnt vmcnt(0)" ::: "memory");
    } else {
      XB_SPIN(xb_ld(&bar[XB_XGEN(b.x)]) == gen, bar);
      __builtin_amdgcn_fence(__ATOMIC_ACQUIRE, "agent");
      asm volatile("s_waitcnt vmcnt(0)" ::: "memory");
    }
  }
  __syncthreads();
}

constexpr int SMEM_MAIN = 65536;
constexpr int SMEM_AGG = 2048;
constexpr int HALF_BYTES = SMEM_MAIN + SMEM_AGG;
constexpr int SMEM_BYTES = 2 * HALF_BYTES + 16;
constexpr int NTHR = 512;

DI void transpose_tile(const float* src, int ldsrc, int src_c0, int ncols_valid, bool ropeperm, const float* gscale, bf16_t* dst, int lddst,
                       int k0, int dst_n0, char* smem) {
  float* tile = (float*)smem;
  const int tid = threadIdx.x, tx = tid & 63, ty = tid >> 6;
  const int sc = ropeperm ? (32 * ((tx >> 2) & 1) + 16 * (tx >> 5) + 4 * ((tx >> 3) & 3) + (tx & 3)) : tx;
  __syncthreads();
  float v[16];
#pragma unroll
  for (int i = 0; i < 16; ++i) v[i] = (src_c0 + sc < ncols_valid) ? src[(size_t)(k0 + ty * 16 + i) * ldsrc + src_c0 + sc] : 0.f;
#pragma unroll
  for (int i = 0; i < 16; ++i) tile[(ty * 16 + i) * 65 + tx] = v[i];
  __syncthreads();
  const int kx = tid & 127, ny = tid >> 7;
  const float g = gscale ? gscale[k0 + kx] : 1.f;
#pragma unroll 4
  for (int i = 0; i < 16; ++i) {
    const int n = ny * 16 + i;
    dst[(size_t)(dst_n0 + n) * lddst + k0 + kx] = f2bf(tile[kx * 65 + n] * g);
  }
}

DI void phase_prep(const Params& p, char* smem) {
  char* ws = p.ws;
  const int tid = threadIdx.x, lane = tid & 63, wid = tid >> 6;
  constexpr int N_WINA = 8 * 28, N_WUQ = 3 * 24, N_WUKV = 2 * 32, N_WOUTA = 128, N_WINB = 8 * 32, N_WRG = 32, N_WIG = 32, N_WOUTB = 128;
  constexpr int T0 = N_WINA, T1 = T0 + N_WUQ, T2 = T1 + N_WUKV, T3 = T2 + N_WOUTA, T4 = T3 + N_WINB, T5 = T4 + N_WRG, T6 = T5 + N_WIG, T7 = T6 + N_WOUTB;
  constexpr int N_ROWS = MP / 8;
  constexpr int N_ROPE = TP * 32 / 512;
  constexpr int TOTAL = T7 + N_ROWS + N_ROPE;
  for (int it = blockIdx.x; it < TOTAL; it += gridDim.x) {
    if (it < T7) {
      if (it < T0)      { int t = it;      const int n0 = (t / 8) * 64; transpose_tile(p.a_w_in, 1728, n0, 1728, n0 == 640, p.a_norm_g, (bf16_t*)(ws + OFF_WINA), 1024, (t % 8) * 128, n0, smem); }
      else if (it < T1) { int t = it - T0; const int n0 = (t / 3) * 64; transpose_tile(p.a_w_uq, 1536, n0, 1536, ((n0 >> 6) % 3) == 2, p.a_q_norm_g, (bf16_t*)(ws + OFF_WUQ), 384, (t % 3) * 128, n0, smem); }
      else if (it < T2) { int t = it - T1; const int n0 = (t / 2) * 64;
                          const int h = n0 >> 8, d = n0 & 255;
                          bf16_t* dstw = (bf16_t*)(ws + (d < 128 ? OFF_WK : OFF_WV));
                          transpose_tile(p.a_w_ukv, 2048, n0, 2048, false, p.a_kv_norm_g, dstw, 256, (t % 2) * 128, h * 128 + (d & 127), smem); }
      else if (it < T3) { int t = it - T2; const int n0 = (t / 8) * 64; transpose_tile(p.a_w_out, 1024, n0, 1024, false, nullptr, (bf16_t*)(ws + OFF_WOUTA), 1024, (t % 8) * 128, n0, smem); }
      else if (it < T4) { int t = it - T3; const int n0 = (t / 8) * 64; transpose_tile(p.b_w_in, 2048, n0, 2048, false, p.b_norm_g, (bf16_t*)(ws + OFF_WINB), 1024, (t % 8) * 128, n0, smem); }
      else if (it < T6) { int t = it - T4; const int n0 = (t >> 1) * 64, k0 = (t & 1) * 128;
                          const int pn = n0 >> 8, hf = (n0 >> 7) & 1, ch0 = 128 * pn + (n0 & 127), g = ch0 >> 8, j0 = ch0 & 255;
                          transpose_tile((hf ? p.b_w_ig : p.b_w_rg) + g * 65536, 256, j0, 256, false, nullptr, (bf16_t*)(ws + OFF_WRG), 256, k0, n0, smem); }
      else              { int t = it - T6; const int n0 = (t / 8) * 64; transpose_tile(p.b_w_out, 1024, n0, 1024, false, nullptr, (bf16_t*)(ws + OFF_WOUTB), 1024, (t % 8) * 128, n0, smem); }
    } else if (it < T7 + N_ROWS) {
      const int row = (it - T7) * 8 + wid;
      const int b = row / TP, pp = row % TP;
      bf16_t* dst = (bf16_t*)(ws + OFF_XN0) + (size_t)row * DM;
      float* rinv0 = (float*)(ws + OFF_RINV0);
      if (pp < PAD) {
#pragma unroll
        for (int i = 0; i < 4; ++i) *(uint2*)(dst + i * 256 + lane * 4) = make_uint2(0u, 0u);
        if (lane == 0) rinv0[row] = 0.f;
      } else {
        const int pos = pp - PAD;
        const float* src = pos < NMETA ? p.meta + pos * DM : p.x + ((size_t)b * SEQ + (pos - NMETA)) * DM;
        float ss = 0.f;
        float4 v[4];
#pragma unroll
        for (int i = 0; i < 4; ++i) { v[i] = *(const float4*)(src + i * 256 + lane * 4); ss += v[i].x * v[i].x + v[i].y * v[i].y + v[i].z * v[i].z + v[i].w * v[i].w; }
#pragma unroll
        for (int o = 32; o >= 1; o >>= 1) ss += __shfl_xor(ss, o);
#pragma unroll
        for (int i = 0; i < 4; ++i) *(uint2*)(dst + i * 256 + lane * 4) = make_uint2(pack2(v[i].x, v[i].y), pack2(v[i].z, v[i].w));
        if (lane == 0) rinv0[row] = rsqrtf(ss * (1.f / 1024.f) + RMS_EPS);
      }
    } else {
      const int e = (it - T7 - N_ROWS) * 512 + tid;
      const int pp = e >> 5, i = e & 31;
      const float inv_freq = __builtin_amdgcn_exp2f(-(float)i * (13.287712379549449f / 32.f));
      const float ang = (float)(pp - PAD) * inv_freq;
      const double rev = (double)ang * 0.15915494309189535;
      const float fr_ = (float)(rev - rint(rev));
      const float s = __builtin_amdgcn_sinf(fr_), c = __builtin_amdgcn_cosf(fr_);
      ((float*)(ws + OFF_ROPEC))[e] = c;
      ((float*)(ws + OFF_ROPES))[e] = s;
    }
  }
}

DI int koff(int key, int ch) { return key * 384 + (((ch & ~7) | ((ch ^ (key >> 1)) & 7)) << 4); }
DI int voff(int dv, int ch) { return dv * 128 + ((ch ^ ((dv >> 1) & 7)) << 4); }

DI void attn_item(const Params& p, int b, int h, int j, char* smem) {
  char* ws = p.ws;
  const int tid = threadIdx.x, lane = tid & 63, w = tid >> 6;
  const int r = lane & 31, hh = lane >> 5;
  const int wq0 = 256 * j - 128 + 32 * w;
  const bool wactive = (wq0 + 31 >= PAD);
  const int q_pp = wq0 + r;
  const int bh = b * 8 + h;
  bf16x8 qf[12];
  if (wactive) {
    const bf16_t* Qp = (const bf16_t*)(ws + OFF_Q) + ((size_t)bh * TP + q_pp) * 192 + hh * 8;
#pragma unroll
    for (int ks = 0; ks < 12; ++ks) qf[ks] = *(const bf16x8*)(Qp + ks * 16);
  } else {
#pragma unroll
    for (int ks = 0; ks < 12; ++ks) qf[ks] = bf16x8{0, 0, 0, 0, 0, 0, 0, 0};
  }
  f32x16 o[4];
#pragma unroll
  for (int d = 0; d < 4; ++d)
#pragma unroll
    for (int i = 0; i < 16; ++i) o[d][i] = 0.f;
  float m_i = -INFINITY, l_i = 0.f;
  const bf16_t* KNb = (const bf16_t*)(ws + OFF_KN) + (size_t)bh * TP * 128;
  const bf16_t* KRb = (const bf16_t*)(ws + OFF_KROPE) + (size_t)b * TP * 64;
  const bf16_t* VTb = (const bf16_t*)(ws + OFF_VT) + (size_t)bh * 128 * TP;
  const int pir = (r & 19) | ((r & 4) << 1) | ((r & 8) >> 1);
  const int nlast = 4 * j + 1;
  const int kn_key = tid >> 4, kn_ch = tid & 15;
  const int kr_key = tid >> 3, kr_ch = tid & 7;
  const int v_dv = tid >> 3, v_ch = tid & 7;
  u32x4 st0, st1, st2, st3, st4;
#define ATT_LOAD(kt) do { \
    st0 = *(const u32x4*)(KNb + (size_t)((kt) * 64 + kn_key) * 128 + kn_ch * 8); \
    st1 = *(const u32x4*)(KNb + (size_t)((kt) * 64 + 32 + kn_key) * 128 + kn_ch * 8); \
    st2 = *(const u32x4*)(KRb + (size_t)((kt) * 64 + kr_key) * 64 + kr_ch * 8); \
    st3 = *(const u32x4*)(VTb + (size_t)v_dv * TP + (kt) * 64 + v_ch * 8); \
    st4 = *(const u32x4*)(VTb + (size_t)(v_dv + 64) * TP + (kt) * 64 + v_ch * 8); } while (0)
#define ATT_STORE(buf) do { char* Kd = smem + (buf) * 40960; char* Vd = Kd + 24576; \
    *(u32x4*)(Kd + koff(kn_key, kn_ch)) = st0; *(u32x4*)(Kd + koff(32 + kn_key, kn_ch)) = st1; \
    *(u32x4*)(Kd + koff(kr_key, 16 + kr_ch)) = st2; \
    *(u32x4*)(Vd + voff(v_dv, v_ch)) = st3; *(u32x4*)(Vd + voff(v_dv + 64, v_ch)) = st4; } while (0)
  __syncthreads();
  int kb[4], vb[4];
#pragma unroll
  for (int q = 0; q < 4; ++q) {
    kb[q] = pir * 384 + ((((2 * q + hh) ^ (pir >> 1)) & 7) << 4);
    vb[q] = r * 128 + ((((2 * q + hh) ^ (r >> 1)) & 7) << 4);
  }
  const int grp = w >> 2;
  ATT_LOAD(1);
  ATT_STORE(1);
  if (nlast >= 2) ATT_LOAD(2);
  __syncthreads();
  if (grp == 1) __builtin_amdgcn_s_barrier();
  for (int kt = 1; kt <= nlast; ++kt) {
    const char* Ks = smem + (kt & 1) * 40960; const char* Vs = Ks + 24576;
    const int kmin = kt * 64;
    const bool work = wactive && kmin <= wq0 + 31;
    f32x16 s0, s1;
#pragma unroll
    for (int i = 0; i < 16; ++i) { s0[i] = 0.f; s1[i] = 0.f; }
    if (work) {
      __builtin_amdgcn_s_setprio(1);
#pragma unroll
      for (int ks = 0; ks < 12; ++ks) {
        const bf16x8 a0 = *(const bf16x8*)(Ks + kb[ks & 3] + (ks >> 2) * 128);
        const bf16x8 a1 = *(const bf16x8*)(Ks + kb[ks & 3] + (ks >> 2) * 128 + 32 * 384);
        s0 = mfma32(a0, qf[ks], s0);
        s1 = mfma32(a1, qf[ks], s1);
      }
      __builtin_amdgcn_s_setprio(0);
    }
    if (grp == 1 && kt < nlast) { ATT_STORE((kt + 1) & 1); if (kt + 2 <= nlast) ATT_LOAD(kt + 2); }
    __syncthreads();
    if (work) {
      if (kt == 1 || kmin + 63 > wq0) {
#pragma unroll
        for (int i = 0; i < 16; ++i) {
          const int kl = (i & 3) + 4 * ((i >> 2) & 1) + 8 * hh + 16 * ((i >> 3) & 1);
          const int k0 = kmin + kl, k1 = kmin + 32 + kl;
          if (!(k0 <= q_pp && k0 >= PAD)) s0[i] = -1e30f;
          if (!(k1 <= q_pp && k1 >= PAD)) s1[i] = -1e30f;
        }
      }
      float mx = s0[0];
#pragma unroll
      for (int i = 1; i < 16; ++i) mx = fmaxf(mx, s0[i]);
#pragma unroll
      for (int i = 0; i < 16; ++i) mx = fmaxf(mx, s1[i]);
      mx = fmaxf(mx, __shfl_xor(mx, 32));
      if (!__all(mx - m_i <= 6.f)) {
        const float m_new = fmaxf(m_i, mx);
        const float alpha = __builtin_amdgcn_exp2f(m_i - m_new);
        m_i = m_new;
        l_i *= alpha;
#pragma unroll
        for (int d = 0; d < 4; ++d)
#pragma unroll
          for (int i = 0; i < 16; ++i) o[d][i] *= alpha;
      }
      float rsum = 0.f;
#pragma unroll
      for (int i = 0; i < 16; ++i) { s0[i] = __builtin_amdgcn_exp2f(s0[i] - m_i); rsum += s0[i]; }
#pragma unroll
      for (int i = 0; i < 16; ++i) { s1[i] = __builtin_amdgcn_exp2f(s1[i] - m_i); rsum += s1[i]; }
      l_i += rsum;
#pragma unroll
      for (int t2 = 0; t2 < 2; ++t2)
#pragma unroll
        for (int sp = 0; sp < 2; ++sp) {
          const f32x16& sx = t2 ? s1 : s0;
          const uint4 pk = make_uint4(pack2(sx[8 * sp + 0], sx[8 * sp + 1]), pack2(sx[8 * sp + 2], sx[8 * sp + 3]),
                                      pack2(sx[8 * sp + 4], sx[8 * sp + 5]), pack2(sx[8 * sp + 6], sx[8 * sp + 7]));
          const bf16x8 pf = __builtin_bit_cast(bf16x8, pk);
#pragma unroll
          for (int d = 0; d < 4; ++d) {
            const bf16x8 vf = *(const bf16x8*)(Vs + vb[2 * t2 + sp] + d * 4096);
            o[d] = mfma32(vf, pf, o[d]);
          }
        }
    }
    if (grp == 0 && kt < nlast) { ATT_STORE((kt + 1) & 1); if (kt + 2 <= nlast) ATT_LOAD(kt + 2); }
    __syncthreads();
  }
  if (grp == 0) __builtin_amdgcn_s_barrier();
#undef ATT_LOAD
#undef ATT_STORE
  if (wactive) {
    const float ltot = l_i + __shfl_xor(l_i, 32);
    const float inv = __builtin_amdgcn_rcpf(ltot);
    const size_t row = (size_t)b * TP + q_pp;
    const bf16_t* ga = (const bf16_t*)(ws + OFF_GATEA) + row * 1024 + h * 128;
    bf16_t* y = (bf16_t*)(ws + OFF_Y) + row * 1024 + h * 128;
    uint2 gvs[4][4];
#pragma unroll
    for (int d = 0; d < 4; ++d)
#pragma unroll
      for (int g4 = 0; g4 < 4; ++g4) gvs[d][g4] = *(const uint2*)(ga + d * 32 + 8 * g4 + 4 * hh);
#pragma unroll
    for (int d = 0; d < 4; ++d)
#pragma unroll
      for (int g4 = 0; g4 < 4; ++g4) {
        const int dv0 = d * 32 + 8 * g4 + 4 * hh;
        const uint2 gv = gvs[d][g4];
        const float y0 = o[d][4 * g4 + 0] * inv * bflo(gv.x), y1 = o[d][4 * g4 + 1] * inv * bfhi(gv.x);
        const float y2 = o[d][4 * g4 + 2] * inv * bflo(gv.y), y3 = o[d][4 * g4 + 3] * inv * bfhi(gv.y);
        *(uint2*)(y + dv0) = make_uint2(pack2(y0, y1), pack2(y2, y3));
      }
  }
}

DI void phase_attn(const Params& p, char* smem) {
  constexpr int NQT = 17;
  constexpr int total = NB * 8 * NQT;
  const int G = gridDim.x;
  for (int rd = 0; rd * G < total; ++rd) {
    const int it = rd * G + ((rd & 1) ? (G - 1 - (int)blockIdx.x) : (int)blockIdx.x);
    if (it >= total) continue;
    const int j = NQT - 1 - it / 64, bh = it % 64;
    attn_item(p, bh >> 3, bh & 7, j, smem);
  }
}

DI void phase_rg2(const Params& p) {
  char* ws = p.ws;
  const int gt = blockIdx.x * NTHR + threadIdx.x;
  if (gt < NB * 1024) {
    const int b = gt >> 10, ch = gt & 1023;
    const float* CA = (const float*)(ws + OFF_CARA) + (size_t)b * NCH * 1024 + ch;
    const float* CB = (const float*)(ws + OFF_CARB) + (size_t)b * NCH * 1024 + ch;
    float* CI = (float*)(ws + OFF_CARIN) + (size_t)b * NCH * 1024 + ch;
    float c = 0.f;
#pragma unroll 1
    for (int j0 = 0; j0 < NCH; j0 += 22) {
      float a[22], bb[22];
#pragma unroll
      for (int k = 0; k < 22; ++k) { a[k] = CA[(j0 + k) * 1024]; bb[k] = CB[(j0 + k) * 1024]; }
#pragma unroll
      for (int k = 0; k < 22; ++k) { CI[(j0 + k) * 1024] = c; c = a[k] * c + bb[k]; }
    }
  }
}

DI void phase_rg3(const Params& p) {
  char* ws = p.ws;
  const size_t total = (size_t)MP * 128;
  bf16_t* HSL = (bf16_t*)(ws + OFF_HSL);
  const bf16_t* PC = (const bf16_t*)(ws + OFF_PCUM);
  const bf16_t* GB = (const bf16_t*)(ws + OFF_GATEB);
  const float* CI = (const float*)(ws + OFF_CARIN);
  for (size_t e = (size_t)blockIdx.x * NTHR + threadIdx.x; e < total; e += (size_t)gridDim.x * NTHR) {
    const int row = (int)(e >> 7), c8 = (int)(e & 127) * 8;
    const int j = row >> 6;
    const uint4 hv = *(const uint4*)(HSL + (size_t)row * 1024 + c8);
    const uint4 pv = *(const uint4*)(PC + (size_t)row * 1024 + c8);
    const uint4 gv = *(const uint4*)(GB + (size_t)row * 1024 + c8);
    const float4 c0 = *(const float4*)(CI + (size_t)j * 1024 + c8), c1 = *(const float4*)(CI + (size_t)j * 1024 + c8 + 4);
    uint4 ov;
    ov.x = pack2((bflo(hv.x) + bflo(pv.x) * c0.x) * bflo(gv.x), (bfhi(hv.x) + bfhi(pv.x) * c0.y) * bfhi(gv.x));
    ov.y = pack2((bflo(hv.y) + bflo(pv.y) * c0.z) * bflo(gv.y), (bfhi(hv.y) + bfhi(pv.y) * c0.w) * bfhi(gv.y));
    ov.z = pack2((bflo(hv.z) + bflo(pv.z) * c1.x) * bflo(gv.z), (bfhi(hv.z) + bfhi(pv.z) * c1.y) * bfhi(gv.z));
    ov.w = pack2((bflo(hv.w) + bflo(pv.w) * c1.z) * bflo(gv.w), (bfhi(hv.w) + bfhi(pv.w) * c1.w) * bfhi(gv.w));
    *(uint4*)(HSL + (size_t)row * 1024 + c8) = ov;
  }
}

DI void phase_final(const Params& p) {
  char* ws = p.ws;
  const int lane = threadIdx.x & 63, wid = threadIdx.x >> 6;
  const bf16_t* H = (const bf16_t*)(ws + OFF_H1);
  const float* ssq2 = (const float*)(ws + OFF_SSQ2);
  for (int it = blockIdx.x; it < NB * SEQ / 8; it += gridDim.x) {
    const int orow = it * 8 + wid;
    const int b = orow >> 12, s = orow & 4095;
    const int row = b * TP + PAD + NMETA + s;
    float ss = 0.f;
    { const float v = (lane < 32) ? ssq2[(size_t)row * 32 + lane] : 0.f; ss = v; }
    uint4 hv[2];
#pragma unroll
    for (int i = 0; i < 2; ++i) hv[i] = *(const uint4*)(H + (size_t)row * 1024 + i * 512 + lane * 8);
#pragma unroll
    for (int o = 16; o >= 1; o >>= 1) ss += __shfl_xor(ss, o);
    ss = __shfl(ss, 0);
    const float sc = rsqrtf(ss * (1.f / 1024.f) + RMS_EPS);
#pragma unroll
    for (int i = 0; i < 2; ++i) {
      const int col = i * 512 + lane * 8;
      const float4 g0 = *(const float4*)(p.final_norm_g + col), g1 = *(const float4*)(p.final_norm_g + col + 4);
      const uint4 h = hv[i];
      *(float4*)(p.out + (size_t)orow * 1024 + col) = make_float4(bflo(h.x) * sc * g0.x, bfhi(h.x) * sc * g0.y, bflo(h.y) * sc * g0.z, bfhi(h.y) * sc * g0.w);
      *(float4*)(p.out + (size_t)orow * 1024 + col + 4) = make_float4(bflo(h.z) * sc * g1.x, bfhi(h.z) * sc * g1.y, bflo(h.w) * sc * g1.z, bfhi(h.w) * sc * g1.w);
    }
  }
}

namespace pg8 {
#define PG8_LAS __attribute__((address_space(3)))
typedef unsigned short bf16_t;
typedef short bf16x8 __attribute__((ext_vector_type(8)));
typedef float f32x4 __attribute__((ext_vector_type(4)));
typedef unsigned u32x4 __attribute__((ext_vector_type(4)));
constexpr int BM = 256, BK = 64, HALF = 128, HTB = HALF * BK * 2  , STAGE_BYTES = 8 * HTB, NXCD = 8, WGM = 8;

__host__ __device__ __forceinline__ int lds_byte(int r, int c) { const int st = (r >> 4) * 2 + (c >> 5), rr = r & 15, cc = c & 31, ob = rr * 64 + cc * 2; return st * 1024 + (ob ^ (((ob >> 9) & 1) << 5)); }
__host__ __device__ __forceinline__ void stage_rc(int b, int& R, int& C) { const int st = b / 1024, sb = b % 1024, swz = sb ^ (((sb >> 9) & 1) << 5); R = (st >> 1) * 16 + swz / 64; C = (st & 1) * 32 + (swz % 64) / 2; }
__host__ __device__ __forceinline__ int perm32(int rho) { const int n = rho >> 4, i = rho & 15; return 8 * (i >> 2) + 4 * n + (i & 3); }
struct Unit { int pm, pn; };
struct Gemm { const bf16_t* A; const bf16_t* Bt; int M, N, K, lda, ldb, a_pn_bytes; };

struct StaticOrder {
    int nM, nN, nwg, G, c;
    __host__ __device__ void init(int M, int N, int G_, int c_) { nM = M / BM; nN = N / BM; nwg = nM * nN; G = G_; c = c_; }
    __host__ __device__ bool next(int i, Unit& u) const {
        const long L = (long)i * G + c; if (L >= nwg) return false;
        int wgid = (int)L; { const int q = nwg / NXCD, r = nwg % NXCD, xcd = wgid % NXCD, off = wgid / NXCD; wgid = (xcd < r ? xcd * (q + 1) : r * (q + 1) + (xcd - r) * q) + off; }
        const int nig = WGM * nN, gid = wgid / nig, fm = gid * WGM, gsz = (nM - fm) < WGM ? (nM - fm) : WGM;
        u.pm = fm + ((wgid % nig) % gsz); u.pn = (wgid % nig) / gsz; return true;
    }
    __device__ __forceinline__ void a_ready(const Unit&) const {}
    __device__ __forceinline__ void done(const Unit&) const {}
};
template <class Epi, class Sched, bool STAMP = false>
__device__ __forceinline__ void gemm_phase(PG8_LAS unsigned char* lds, const Gemm g, const Sched& S, const Epi& E, unsigned long long* stamps) {
    int tid_ = threadIdx.x; asm volatile("" : "+v"(tid_));
    const int tid = tid_, wid = __builtin_amdgcn_readfirstlane(tid >> 6), lane = tid & 63, wr = wid >> 2, wc = wid & 3, fr = lane & 15, fq = lane >> 4;
    const int K = g.K, nt = K / BK;
    int ts_lo = 0, ts_hi = 0, nts = 0; const unsigned long long rt_entry = STAMP ? (unsigned long long)wall_clock64() : 0ull;
#define PG8_STAMP() do { if (STAMP && wid == 0 && nts < 64) { const unsigned long long _c = (unsigned long long)clock64(); \
        ts_lo = (lane == nts) ? (int)(unsigned)_c : ts_lo; ts_hi = (lane == nts) ? (int)(unsigned)(_c >> 32) : ts_hi; ++nts; } } while (0)
    PG8_STAMP();
    unsigned voffA[2], voffB[2];
#pragma unroll
    for (int i = 0; i < 2; ++i) { int R, C; stage_rc(tid * 16 + i * 8192, R, C); const int Rb = Epi::PERM ? ((R & ~31) + perm32(R & 31)) : R;
        voffA[i] = (unsigned)(R * g.lda + C) * 2u; voffB[i] = (unsigned)(Rb * g.ldb + C) * 2u; }
    const size_t kstep = (size_t)(BK * 2);
    const size_t hstepA = (size_t)HALF * g.lda * 2, hstepB = (size_t)HALF * g.ldb * 2;
    const size_t tstepA = 2 * hstepA, tstepB = 2 * hstepB;
    const unsigned ldsw = (unsigned)wid * 1024u;
    const int aoff = lds_byte(wr * 64 + fr, fq * 8), boff = lds_byte(wc * 32 + fr, fq * 8);
#define PG8_SA(b, h) (((b) * 2 + (h)) * HTB)
#define PG8_SB(b, h) ((4 + (b) * 2 + (h)) * HTB)
#define PG8_STAGE(bufoff, gbase, voff) do { _Pragma("unroll") for (int _i = 0; _i < 2; ++_i) \
        __builtin_amdgcn_global_load_lds((const unsigned*)((const char*)(gbase) + (voff)[_i]), (PG8_LAS unsigned*)(lds + (bufoff) + ldsw + _i * 8192), 16, 0, 0); } while (0)
#define PG8_LDA(dst, b, h) do { _Pragma("unroll") for (int m = 0; m < 4; ++m) _Pragma("unroll") for (int k = 0; k < 2; ++k) dst[m][k] = *(const PG8_LAS bf16x8*)(lds + PG8_SA(b, h) + aoff + m * 2048 + k * 1024); } while (0)
#define PG8_LDB(dst, b, h) do { _Pragma("unroll") for (int n = 0; n < 2; ++n) _Pragma("unroll") for (int k = 0; k < 2; ++k) dst[n][k] = *(const PG8_LAS bf16x8*)(lds + PG8_SB(b, h) + boff + n * 2048 + k * 1024); } while (0)
#define PG8_MMA(ai, bj, At, Bt) do { __builtin_amdgcn_s_setprio(1); _Pragma("unroll") for (int m = 0; m < 4; ++m) _Pragma("unroll") for (int n = 0; n < 2; ++n) _Pragma("unroll") for (int k = 0; k < 2; ++k) \
        acc[ai][bj][m][n] = __builtin_amdgcn_mfma_f32_16x16x32_bf16(Bt[n][k], At[m][k], acc[ai][bj][m][n], 0, 0, 0); __builtin_amdgcn_s_setprio(0); } while (0)
#define PG8_WAIT_V(n) asm volatile("s_waitcnt vmcnt(" #n ")" ::: "memory")
#define PG8_WAIT_L(n) asm volatile("s_waitcnt lgkmcnt(" #n ")" ::: "memory")
#define PG8_BAR __builtin_amdgcn_s_barrier()
#define PG8_SCHED __builtin_amdgcn_sched_barrier(0)
    Unit cur, nxt; int ui = 0;
    if (!S.next(0, cur)) return;
    f32x4 acc[2][2][4][2];
#pragma unroll
    for (int a = 0; a < 2; ++a)
#pragma unroll
        for (int b = 0; b < 2; ++b)
#pragma unroll
            for (int m = 0; m < 4; ++m)
#pragma unroll
                for (int n = 0; n < 2; ++n) acc[a][b][m][n] = (f32x4){0.f, 0.f, 0.f, 0.f};
    bf16x8 At[4][2], B0[2][2], B1[2][2];
    const char* cA = (const char*)g.A + (size_t)cur.pm * tstepA + (size_t)(cur.pn >> 1) * g.a_pn_bytes; const char* cB = (const char*)g.Bt + (size_t)cur.pn * tstepB;
    S.a_ready(cur);
    PG8_STAGE(PG8_SB(0, 0), cB, voffB); PG8_STAGE(PG8_SA(0, 0), cA, voffA); PG8_STAGE(PG8_SB(0, 1), cB + hstepB, voffB); PG8_STAGE(PG8_SA(0, 1), cA + hstepA, voffA);
    if (wr == 1) PG8_BAR;
    PG8_WAIT_V(4); PG8_BAR;
    PG8_STAGE(PG8_SB(1, 0), cB + kstep, voffB); PG8_STAGE(PG8_SA(1, 0), cA + kstep, voffA); PG8_STAGE(PG8_SB(1, 1), cB + hstepB + kstep, voffB);
    PG8_WAIT_V(6); PG8_BAR;
    PG8_STAMP();
    for (;;) {
        const bool has_next = S.next(ui + 1, nxt);
        const char* nA = has_next ? (const char*)g.A + (size_t)nxt.pm * tstepA + (size_t)(nxt.pn >> 1) * g.a_pn_bytes : cA; const char* nB = has_next ? (const char*)g.Bt + (size_t)nxt.pn * tstepB : cB;
#pragma unroll 1
        for (int t = 0; t < nt; t += 2) {
            const bool last = (t == nt - 2);
            const char* a1 = cA + (size_t)(t + 1) * kstep;
            const char* a2 = last ? nA : cA + (size_t)(t + 2) * kstep; const char* b2 = last ? nB : cB + (size_t)(t + 2) * kstep;
            const char* a3 = a2 + kstep; const char* b3 = b2 + kstep;
            if (last && has_next) S.a_ready(nxt);
            PG8_LDB(B0, 0, 0); PG8_SCHED; PG8_LDA(At, 0, 0); PG8_STAGE(PG8_SA(1, 1), a1 + hstepA, voffA);
            PG8_WAIT_L(8); PG8_BAR; PG8_WAIT_L(0); PG8_MMA(0, 0, At, B0); PG8_BAR; PG8_SCHED;
            PG8_LDB(B1, 0, 1); PG8_STAGE(PG8_SB(0, 0), b2, voffB);
            PG8_BAR; PG8_WAIT_L(0); PG8_MMA(0, 1, At, B1); PG8_BAR;
            PG8_LDA(At, 0, 1); PG8_STAGE(PG8_SA(0, 0), a2, voffA);
            PG8_BAR; PG8_WAIT_L(0); PG8_MMA(1, 0, At, B0); PG8_BAR; PG8_SCHED;
            PG8_STAGE(PG8_SB(0, 1), b2 + hstepB, voffB);
            PG8_WAIT_V(6); PG8_BAR; PG8_MMA(1, 1, At, B1); PG8_BAR;
            PG8_LDB(B0, 1, 0); PG8_SCHED; PG8_LDA(At, 1, 0); PG8_STAGE(PG8_SA(0, 1), a2 + hstepA, voffA);
            PG8_WAIT_L(8); PG8_BAR; PG8_WAIT_L(0); PG8_MMA(0, 0, At, B0); PG8_BAR; PG8_SCHED;
            PG8_LDB(B1, 1, 1); PG8_STAGE(PG8_SB(1, 0), b3, voffB);
            PG8_BAR; PG8_WAIT_L(0); PG8_MMA(0, 1, At, B1); PG8_BAR;
            PG8_LDA(At, 1, 1); PG8_STAGE(PG8_SA(1, 0), a3, voffA);
            PG8_BAR; PG8_WAIT_L(0); PG8_MMA(1, 0, At, B0); PG8_BAR; PG8_SCHED;
            PG8_STAGE(PG8_SB(1, 1), b3 + hstepB, voffB);
            PG8_WAIT_V(6); PG8_BAR; PG8_MMA(1, 1, At, B1); PG8_BAR;
        }
        PG8_STAMP();
        if constexpr (!Epi::AFTER_DRAIN) { E(acc, cur, wr, wc, fr, fq); S.done(cur); }
        PG8_STAMP();
        if (!has_next) break;
#pragma unroll
        for (int a = 0; a < 2; ++a)
#pragma unroll
            for (int b = 0; b < 2; ++b)
#pragma unroll
                for (int m = 0; m < 4; ++m)
#pragma unroll
                    for (int n = 0; n < 2; ++n) acc[a][b][m][n] = (f32x4){0.f, 0.f, 0.f, 0.f};
        cur = nxt; cA = nA; cB = nB; ++ui;
    }
    PG8_WAIT_V(0);
    if (wr == 0) PG8_BAR;
    PG8_BAR;
    if constexpr (Epi::AFTER_DRAIN) { E.fused(acc, cur, wr, wc, fr, fq, lds, wid, lane); S.done(cur); }
    PG8_STAMP();
    if (STAMP && wid == 0) { stamps[lane] = lane < nts ? (((unsigned long long)(unsigned)ts_hi << 32) | (unsigned)ts_lo) : 0ull;
        if (lane == 62) stamps[62] = rt_entry; if (lane == 63) stamps[63] = (unsigned long long)wall_clock64(); }
#undef PG8_STAMP
#undef PG8_SA
#undef PG8_SB
#undef PG8_STAGE
#undef PG8_LDA
#undef PG8_LDB
#undef PG8_MMA
#undef PG8_WAIT_V
#undef PG8_WAIT_L
#undef PG8_BAR
#undef PG8_SCHED
}
}


namespace pg8 {
struct GDesc { const bf16_t* A; const bf16_t* Bt; int lda, ldb, nt, nM, nN, a_pn_bytes, dep, dep_need, dep_on_b, pub; };
struct MUnit { int pm, pn, gid; };
constexpr int RDY_PANELS = 136;
struct CDesc { size_t offA, offB; int lda, ldb, nt, nM, nN, a_pn_bytes, dep, dep_need, dep_on_b, pub; };
template <class T> struct MultiOrder {
  char* ws; int G, c; unsigned* ready; unsigned* tmo;
  static constexpr int off1 = T::d[0].nM * T::d[0].nN, off2 = off1 + T::d[1].nM * T::d[1].nN, off3 = off2 + T::d[2].nM * T::d[2].nN;
  __device__ __forceinline__ GDesc desc(int gid) const {
    GDesc r;
#define PG8_SEL(f) (gid == 0 ? T::d[0].f : (gid == 1 ? T::d[1].f : T::d[2].f))
    r.A = (const bf16_t*)(ws + PG8_SEL(offA)); r.Bt = (const bf16_t*)(ws + PG8_SEL(offB));
    r.lda = PG8_SEL(lda); r.ldb = PG8_SEL(ldb); r.nt = PG8_SEL(nt); r.nM = PG8_SEL(nM); r.nN = PG8_SEL(nN); r.a_pn_bytes = PG8_SEL(a_pn_bytes);
    r.dep = PG8_SEL(dep); r.dep_need = PG8_SEL(dep_need); r.dep_on_b = PG8_SEL(dep_on_b); r.pub = PG8_SEL(pub);
#undef PG8_SEL
    return r;
  }
  __device__ __forceinline__ bool next(int i, MUnit& u) const {
    const int L = i * G + c; if (L >= off3) return false;
    const int gid = L < off1 ? 0 : (L < off2 ? 1 : 2);
    const int base = gid == 0 ? 0 : (gid == 1 ? off1 : off2);
    const int nM = gid == 0 ? T::d[0].nM : (gid == 1 ? T::d[1].nM : T::d[2].nM), nN = gid == 0 ? T::d[0].nN : (gid == 1 ? T::d[1].nN : T::d[2].nN);
    int wgid = L - base; const int nwg = nM * nN;
    { const int q = nwg / NXCD, r = nwg % NXCD, xcd = wgid % NXCD, o = wgid / NXCD; wgid = (xcd < r ? xcd * (q + 1) : r * (q + 1) + (xcd - r) * q) + o; }
    const int nig = WGM * nN, grp = wgid / nig, fm = grp * WGM, gsz = (nM - fm) < WGM ? (nM - fm) : WGM;
    u.pm = fm + ((wgid % nig) % gsz); u.pn = (wgid % nig) / gsz; u.gid = gid; return true;
  }
  __device__ __forceinline__ void a_ready(const MUnit& u) const {
    const GDesc g = desc(u.gid);
    if (g.dep < 0) return;
    if (threadIdx.x < 64) {
      const unsigned* w = ready + (size_t)(g.dep * RDY_PANELS + (g.dep_on_b ? u.pn : u.pm)) * 64;
      const unsigned long long t0 = __builtin_amdgcn_s_memrealtime(); unsigned polls = 0;
      while ((unsigned)__builtin_amdgcn_readfirstlane(__hip_atomic_load(w, __ATOMIC_RELAXED, __HIP_MEMORY_SCOPE_AGENT)) < (unsigned)g.dep_need) {
        if ((++polls & 255u) == 0u && __builtin_amdgcn_readfirstlane(__hip_atomic_load(tmo, __ATOMIC_RELAXED, __HIP_MEMORY_SCOPE_AGENT)) != 0u) break;
        if (__builtin_amdgcn_s_memrealtime() - t0 > 2000000ull) { if (threadIdx.x == 0) __hip_atomic_store(tmo, 1u, __ATOMIC_RELAXED, __HIP_MEMORY_SCOPE_AGENT); break; }
        __builtin_amdgcn_s_sleep(2); }
      __builtin_amdgcn_fence(__ATOMIC_ACQUIRE, "agent");
      asm volatile("s_waitcnt vmcnt(0)" ::: "memory");
    }
    asm volatile("" ::: "memory"); __builtin_amdgcn_s_barrier(); asm volatile("" ::: "memory");
  }
  __device__ __forceinline__ void done(const MUnit& u) const {
    const GDesc g = desc(u.gid);
    if (g.pub < 0) return;
    asm volatile("s_waitcnt vmcnt(0)" ::: "memory");
    __builtin_amdgcn_fence(__ATOMIC_RELEASE, "agent");
    asm volatile("s_waitcnt vmcnt(0)" ::: "memory");
    if ((threadIdx.x & 63) == 0) __hip_atomic_fetch_add(ready + (size_t)(g.pub * RDY_PANELS + u.pm) * 64, 1u, __ATOMIC_RELAXED, __HIP_MEMORY_SCOPE_AGENT);
  }
};

template <class Epi, class Sched>
__device__ __forceinline__ void gemm_stream(PG8_LAS unsigned char* lds, const Sched& S, const Epi& E) {
    int tid_ = threadIdx.x; asm volatile("" : "+v"(tid_));
    const int tid = tid_, wid = __builtin_amdgcn_readfirstlane(tid >> 6), lane = tid & 63, wr = wid >> 2, wc = wid & 3, fr = lane & 15, fq = lane >> 4;
    int sR0, sR1, sB0, sB1, sC0, sC1;
    { int R, C; stage_rc(tid * 16, R, C); sR0 = R; sC0 = C * 2; sB0 = (R & ~31) + perm32(R & 31);
      stage_rc(tid * 16 + 8192, R, C); sR1 = R; sC1 = C * 2; sB1 = (R & ~31) + perm32(R & 31); }
    const int kstep = BK * 2;
    const unsigned ldsw = (unsigned)wid * 1024u;
    const int aoff = lds_byte(wr * 64 + fr, fq * 8), boff = lds_byte(wc * 32 + fr, fq * 8);
#define PG8_SA(b, h) (((b) * 2 + (h)) * HTB)
#define PG8_SB(b, h) ((4 + (b) * 2 + (h)) * HTB)
#define PG8_STAGE2(bufoff, gbase, r0, r1, ld2) do { \
        __builtin_amdgcn_global_load_lds((const unsigned*)((const char*)(gbase) + (unsigned)((r0) * (ld2) + sC0)), (PG8_LAS unsigned*)(lds + (bufoff) + ldsw), 16, 0, 0); \
        __builtin_amdgcn_global_load_lds((const unsigned*)((const char*)(gbase) + (unsigned)((r1) * (ld2) + sC1)), (PG8_LAS unsigned*)(lds + (bufoff) + ldsw + 8192), 16, 0, 0); } while (0)
#define PG8_STA(bufoff, gbase, ld2) PG8_STAGE2(bufoff, gbase, sR0, sR1, ld2)
#define PG8_STB(bufoff, gbase, ld2) PG8_STAGE2(bufoff, gbase, sB0, sB1, ld2)
#define PG8_LDA(dst, b, h) do { _Pragma("unroll") for (int m = 0; m < 4; ++m) _Pragma("unroll") for (int k = 0; k < 2; ++k) dst[m][k] = *(const PG8_LAS bf16x8*)(lds + PG8_SA(b, h) + aoff + m * 2048 + k * 1024); } while (0)
#define PG8_LDB(dst, b, h) do { _Pragma("unroll") for (int n = 0; n < 2; ++n) _Pragma("unroll") for (int k = 0; k < 2; ++k) dst[n][k] = *(const PG8_LAS bf16x8*)(lds + PG8_SB(b, h) + boff + n * 2048 + k * 1024); } while (0)
#define PG8_MMA(ai, bj, At, Bt) do { __builtin_amdgcn_s_setprio(1); _Pragma("unroll") for (int m = 0; m < 4; ++m) _Pragma("unroll") for (int n = 0; n < 2; ++n) _Pragma("unroll") for (int k = 0; k < 2; ++k) \
        acc[ai][bj][m][n] = __builtin_amdgcn_mfma_f32_16x16x32_bf16(Bt[n][k], At[m][k], acc[ai][bj][m][n], 0, 0, 0); __builtin_amdgcn_s_setprio(0); } while (0)
#define PG8_WAIT_V(n) asm volatile("s_waitcnt vmcnt(" #n ")" ::: "memory")
#define PG8_WAIT_L(n) asm volatile("s_waitcnt lgkmcnt(" #n ")" ::: "memory")
#define PG8_BAR __builtin_amdgcn_s_barrier()
#define PG8_SCHED __builtin_amdgcn_sched_barrier(0)
    MUnit cur, nxt; int ui = 0;
    if (!S.next(0, cur)) return;
    f32x4 acc[2][2][4][2];
#pragma unroll
    for (int a = 0; a < 2; ++a)
#pragma unroll
        for (int b = 0; b < 2; ++b)
#pragma unroll
            for (int m = 0; m < 4; ++m)
#pragma unroll
                for (int n = 0; n < 2; ++n) acc[a][b][m][n] = (f32x4){0.f, 0.f, 0.f, 0.f};
    bf16x8 At[4][2], B0[2][2], B1[2][2];
    GDesc gc = S.desc(cur.gid);
    int la2 = gc.lda * 2, lb2 = gc.ldb * 2;
    int hA = HALF * gc.lda * 2, hB = HALF * gc.ldb * 2;
    int nt = gc.nt;
    const char* cA = (const char*)gc.A + (size_t)cur.pm * 2 * hA + (size_t)(cur.pn >> 1) * gc.a_pn_bytes; const char* cB = (const char*)gc.Bt + (size_t)cur.pn * 2 * hB;
    S.a_ready(cur);
    PG8_STB(PG8_SB(0, 0), cB, lb2); PG8_STA(PG8_SA(0, 0), cA, la2); PG8_STB(PG8_SB(0, 1), cB + hB, lb2); PG8_STA(PG8_SA(0, 1), cA + hA, la2);
    if (wr == 1) PG8_BAR;
    PG8_WAIT_V(4); PG8_BAR;
    PG8_STB(PG8_SB(1, 0), cB + kstep, lb2); PG8_STA(PG8_SA(1, 0), cA + kstep, la2); PG8_STB(PG8_SB(1, 1), cB + hB + kstep, lb2);
    PG8_WAIT_V(6); PG8_BAR;
    for (;;) {
        const bool has_next = S.next(ui + 1, nxt);
        GDesc gn = gc; if (has_next) gn = S.desc(nxt.gid);
        const int nla2 = gn.lda * 2, nlb2 = gn.ldb * 2;
        const int nhA = HALF * gn.lda * 2, nhB = HALF * gn.ldb * 2;
        const char* nA = has_next ? (const char*)gn.A + (size_t)nxt.pm * 2 * nhA + (size_t)(nxt.pn >> 1) * gn.a_pn_bytes : cA;
        const char* nB = has_next ? (const char*)gn.Bt + (size_t)nxt.pn * 2 * nhB : cB;
#pragma unroll 1
        for (int t = 0; t < nt; t += 2) {
            const bool last = (t == nt - 2);
            const char* a1 = cA + (t + 1) * kstep;
            const char* a2 = last ? nA : cA + (t + 2) * kstep; const char* b2 = last ? nB : cB + (t + 2) * kstep;
            const char* a3 = a2 + kstep; const char* b3 = b2 + kstep;
            const int xla2 = last ? nla2 : la2, xlb2 = last ? nlb2 : lb2;
            const int xhA = last ? nhA : hA, xhB = last ? nhB : hB;
            if (last && has_next) S.a_ready(nxt);
            PG8_LDB(B0, 0, 0); PG8_SCHED; PG8_LDA(At, 0, 0); PG8_STA(PG8_SA(1, 1), a1 + hA, la2);
            PG8_WAIT_L(8); PG8_BAR; PG8_WAIT_L(0); PG8_MMA(0, 0, At, B0); PG8_BAR; PG8_SCHED;
            PG8_LDB(B1, 0, 1); PG8_STB(PG8_SB(0, 0), b2, xlb2);
            PG8_BAR; PG8_WAIT_L(0); PG8_MMA(0, 1, At, B1); PG8_BAR;
            PG8_LDA(At, 0, 1); PG8_STA(PG8_SA(0, 0), a2, xla2);
            PG8_BAR; PG8_WAIT_L(0); PG8_MMA(1, 0, At, B0); PG8_BAR; PG8_SCHED;
            PG8_STB(PG8_SB(0, 1), b2 + xhB, xlb2);
            PG8_WAIT_V(6); PG8_BAR; PG8_MMA(1, 1, At, B1); PG8_BAR;
            PG8_LDB(B0, 1, 0); PG8_SCHED; PG8_LDA(At, 1, 0); PG8_STA(PG8_SA(0, 1), a2 + xhA, xla2);
            PG8_WAIT_L(8); PG8_BAR; PG8_WAIT_L(0); PG8_MMA(0, 0, At, B0); PG8_BAR; PG8_SCHED;
            PG8_LDB(B1, 1, 1); PG8_STB(PG8_SB(1, 0), b3, xlb2);
            PG8_BAR; PG8_WAIT_L(0); PG8_MMA(0, 1, At, B1); PG8_BAR;
            PG8_LDA(At, 1, 1); PG8_STA(PG8_SA(1, 0), a3, xla2);
            PG8_BAR; PG8_WAIT_L(0); PG8_MMA(1, 0, At, B0); PG8_BAR; PG8_SCHED;
            PG8_STB(PG8_SB(1, 1), b3 + xhB, xlb2);
            PG8_WAIT_V(6); PG8_BAR; PG8_MMA(1, 1, At, B1); PG8_BAR;
        }
        { int fr_ = fr, fq_ = fq; asm volatile("" : "+v"(fr_), "+v"(fq_));
          E(acc, cur, wr, wc, fr_, fq_); }
        S.done(cur);
        if (!has_next) break;
#pragma unroll
        for (int a = 0; a < 2; ++a)
#pragma unroll
            for (int b = 0; b < 2; ++b)
#pragma unroll
                for (int m = 0; m < 4; ++m)
#pragma unroll
                    for (int n = 0; n < 2; ++n) acc[a][b][m][n] = (f32x4){0.f, 0.f, 0.f, 0.f};
        cur = nxt; cA = nA; cB = nB; la2 = nla2; lb2 = nlb2; hA = nhA; hB = nhB; nt = gn.nt; gc = gn; ++ui;
    }
    PG8_WAIT_V(0);
    if (wr == 0) PG8_BAR;
    PG8_BAR;
#undef PG8_SA
#undef PG8_SB
#undef PG8_STAGE2
#undef PG8_STA
#undef PG8_STB
#undef PG8_LDA
#undef PG8_LDB
#undef PG8_MMA
#undef PG8_WAIT_V
#undef PG8_WAIT_L
#undef PG8_BAR
#undef PG8_SCHED
}
}

struct EpiBase { static constexpr bool PERM = true, AFTER_DRAIN = false; char* ws; Params p; };
DI float quad_sum(float v) { v += __shfl_xor(v, 16); v += __shfl_xor(v, 32); return v; }
DI u32x4 pack8(const f32x4& a, const f32x4& b) { u32x4 w; w.x = pack2(a[0], a[1]); w.y = pack2(a[2], a[3]); w.z = pack2(b[0], b[1]); w.w = pack2(b[2], b[3]); return w; }
DI float sumsq8(const f32x4& a, const f32x4& b) { return a[0]*a[0] + a[1]*a[1] + a[2]*a[2] + a[3]*a[3] + b[0]*b[0] + b[1]*b[1] + b[2]*b[2] + b[3]*b[3]; }
DI f32x4 silu4(const f32x4& a) { f32x4 r; r[0] = silu_f(a[0]); r[1] = silu_f(a[1]); r[2] = silu_f(a[2]); r[3] = silu_f(a[3]); return r; }
DI f32x4 ld4(const float* q) { return *(const f32x4*)q; }

struct EpiG1 : EpiBase {
  DI void operator()(const f32x4 (&acc)[2][2][4][2], const pg8::Unit& u, int wr, int wc, int fr, int fq) const {
    const float* rinv0 = (const float*)(ws + OFF_RINV0);
    bf16_t* ql = (bf16_t*)(ws + OFF_QLAT); float* ssqa = (float*)(ws + OFF_SSQA);
    bf16_t* kr = (bf16_t*)(ws + OFF_KROPE); bf16_t* ga = (bf16_t*)(ws + OFF_GATEA);
    const float* rc = (const float*)(ws + OFF_ROPEC); const float* rsn = (const float*)(ws + OFF_ROPES);
    const int rowb = u.pm * 256 + wr * 64 + fr;
    float rsv[2][4];
#pragma unroll
    for (int ai = 0; ai < 2; ++ai)
#pragma unroll
      for (int m = 0; m < 4; ++m) rsv[ai][m] = rinv0[rowb + ai * 128 + m * 16];
    const bool ropeu = (u.pn == 2) && (wc < 2);
    const int ri = 16 * wc + 4 * fq;
    const int b0 = (u.pm * 256) / TP;
#pragma unroll
    for (int ai = 0; ai < 2; ++ai) {
#pragma unroll
      for (int mp = 0; mp < 2; ++mp) {
      f32x4 cs[2], sns[2];
      if (ropeu) {
#pragma unroll
        for (int mm = 0; mm < 2; ++mm) {
          const int row = rowb + ai * 128 + (2 * mp + mm) * 16;
          const int pp = row - (b0 + (row >= (b0 + 1) * TP ? 1 : 0)) * TP;
          cs[mm] = ld4(rc + pp * 32 + ri); sns[mm] = ld4(rsn + pp * 32 + ri);
        }
      }
#pragma unroll
      for (int mm = 0; mm < 2; ++mm) {
        const int m = 2 * mp + mm;
        const int row = rowb + ai * 128 + m * 16;
        const float rs = rsv[ai][m];
#pragma unroll
        for (int bj = 0; bj < 2; ++bj) {
          const int unit = u.pn * 2 + bj;
          const f32x4 v0 = acc[ai][bj][m][0] * rs, v1 = acc[ai][bj][m][1] * rs;
          if (unit < 5) {
            *(u32x4*)(ql + (size_t)row * 640 + unit * 128 + wc * 32 + 8 * fq) = pack8(v0, v1);
            const float ss = quad_sum(sumsq8(v0, v1));
            if (fq == 0) ssqa[(size_t)row * 32 + unit * 4 + wc] = ss;
          } else if (unit == 5 && wc < 2) {
            const int i = ri;
            const f32x4 c = cs[mm], sn = sns[mm];
            const f32x4 o1 = v0 * c - v1 * sn, o2 = v0 * sn + v1 * c;
            *(uint2*)(kr + (size_t)row * 64 + i) = make_uint2(pack2(o1[0], o1[1]), pack2(o1[2], o1[3]));
            *(uint2*)(kr + (size_t)row * 64 + 32 + i) = make_uint2(pack2(o2[0], o2[1]), pack2(o2[2], o2[3]));
          } else {
            const int gc = unit * 128 + wc * 32 + 8 * fq - 704;
            if (gc < 1024) *(u32x4*)(ga + (size_t)row * 1024 + gc) = pack8(silu4(v0), silu4(v1));
          }
        }
      }
      }
    }
  }
};

struct EpiQ : EpiBase {
  DI void operator()(const f32x4 (&acc)[2][2][4][2], const pg8::Unit& u, int wr, int wc, int fr, int fq) const {
    const float* ssqa = (const float*)(ws + OFF_SSQA);
    const float* rc = (const float*)(ws + OFF_ROPEC); const float* rsn = (const float*)(ws + OFF_ROPES);
    bf16_t* Q = (bf16_t*)(ws + OFF_Q);
    float scv[2][4];
    { float2 tq[2][4]; float tr[2][4];
#pragma unroll
      for (int ai = 0; ai < 2; ++ai)
#pragma unroll
        for (int m = 0; m < 4; ++m) { const float* q = ssqa + (size_t)(u.pm * 256 + ai * 128 + wr * 64 + m * 16 + fr) * 32; tq[ai][m] = *(const float2*)(q + 2 * fq); tr[ai][m] = q[8 + fq]; }
#pragma unroll
      for (int ai = 0; ai < 2; ++ai)
#pragma unroll
        for (int m = 0; m < 4; ++m) scv[ai][m] = rsqrtf(quad_sum(tq[ai][m].x + tq[ai][m].y + tr[ai][m]) * (1.f / 384.f) + RMS_EPS) * QSCALE; }
    const int slab0 = (u.pn * 2) * 2 + (wc >> 1), slab1 = slab0 + 2;
    const bool rope0 = (slab0 % 3) == 2, rope1 = (slab1 % 3) == 2;
    const int ri = 16 * (wc & 1) + 4 * fq;
    const int b0 = (u.pm * 256) / TP;
#pragma unroll
    for (int ai = 0; ai < 2; ++ai) {
      f32x4 cs[4], sns[4];
      if (rope0 || rope1) {
#pragma unroll
        for (int m = 0; m < 4; ++m) {
          const int row = u.pm * 256 + ai * 128 + wr * 64 + m * 16 + fr;
          const int pp = row - (b0 + (row >= (b0 + 1) * TP ? 1 : 0)) * TP;
          cs[m] = ld4(rc + pp * 32 + ri); sns[m] = ld4(rsn + pp * 32 + ri);
        }
      }
#pragma unroll
      for (int m = 0; m < 4; ++m) {
        const int row = u.pm * 256 + ai * 128 + wr * 64 + m * 16 + fr;
        const int b = b0 + (row >= (b0 + 1) * TP ? 1 : 0), pp = row - b * TP;
        const float sc = scv[ai][m];
#pragma unroll
        for (int bj = 0; bj < 2; ++bj) {
          const int slab = bj ? slab1 : slab0;
          const int head = slab / 3, part = slab % 3;
          bf16_t* qrow = Q + ((size_t)(b * 8 + head) * TP + pp) * 192;
          const f32x4 v0 = acc[ai][bj][m][0] * sc, v1 = acc[ai][bj][m][1] * sc;
          if (part < 2) {
            *(u32x4*)(qrow + part * 64 + (wc & 1) * 32 + 8 * fq) = pack8(v0, v1);
          } else {
            const f32x4 c = cs[m], sn = sns[m];
            const f32x4 o1 = v0 * c - v1 * sn, o2 = v0 * sn + v1 * c;
            *(uint2*)(qrow + 128 + ri) = make_uint2(pack2(o1[0], o1[1]), pack2(o1[2], o1[3]));
            *(uint2*)(qrow + 160 + ri) = make_uint2(pack2(o2[0], o2[1]), pack2(o2[2], o2[3]));
          }
        }
      }
    }
  }
};

DI float kv_scale(const float* ssqa, int row) {
  const f32x4 s0 = ld4(ssqa + (size_t)row * 32 + 12), s1 = ld4(ssqa + (size_t)row * 32 + 16);
  return rsqrtf(((s0[0] + s0[1] + s0[2] + s0[3]) + (s1[0] + s1[1] + s1[2] + s1[3])) * (1.f / 256.f) + RMS_EPS);
}

struct EpiK : EpiBase {
  DI void operator()(const f32x4 (&acc)[2][2][4][2], const pg8::Unit& u, int wr, int wc, int fr, int fq) const {
    const float* ssqa = (const float*)(ws + OFF_SSQA);
    bf16_t* KN = (bf16_t*)(ws + OFF_KN);
    float scv[2][4];
    { float2 tq[2][4];
#pragma unroll
      for (int ai = 0; ai < 2; ++ai)
#pragma unroll
        for (int m = 0; m < 4; ++m) tq[ai][m] = *(const float2*)(ssqa + (size_t)(u.pm * 256 + ai * 128 + wr * 64 + m * 16 + fr) * 32 + 12 + 2 * fq);
#pragma unroll
      for (int ai = 0; ai < 2; ++ai)
#pragma unroll
        for (int m = 0; m < 4; ++m) scv[ai][m] = rsqrtf(quad_sum(tq[ai][m].x + tq[ai][m].y) * (1.f / 256.f) + RMS_EPS); }
#pragma unroll
    for (int ai = 0; ai < 2; ++ai)
#pragma unroll
      for (int m = 0; m < 4; ++m) {
        const int row = u.pm * 256 + ai * 128 + wr * 64 + m * 16 + fr;
        const int b0 = (u.pm * 256) / TP, b = b0 + (row >= (b0 + 1) * TP ? 1 : 0), pp = row - b * TP;
        const float sc = scv[ai][m];
#pragma unroll
        for (int bj = 0; bj < 2; ++bj) {
          const int head = u.pn * 2 + bj;
          *(u32x4*)(KN + ((size_t)(b * 8 + head) * TP + pp) * 128 + wc * 32 + 8 * fq) = pack8(acc[ai][bj][m][0] * sc, acc[ai][bj][m][1] * sc);
        }
      }
  }
};

struct EpiV : EpiBase {
  DI void operator()(const f32x4 (&acc)[2][2][4][2], const pg8::Unit& u, int wr, int wc, int fr, int fq) const {
    const float* ssqa = (const float*)(ws + OFF_SSQA);
    bf16_t* VT = (bf16_t*)(ws + OFF_VT);
#pragma unroll
    for (int bj = 0; bj < 2; ++bj) {
      const int tok0 = u.pn * 256 + bj * 128 + wc * 32 + 8 * fq;
      const int b0 = (u.pn * 256) / TP, b = b0 + (tok0 >= (b0 + 1) * TP ? 1 : 0), pp0 = tok0 - b * TP;
      f32x4 sc0, sc1;
      { const float mine = kv_scale(ssqa, tok0 + (fr & 7));
#pragma unroll
        for (int j = 0; j < 4; ++j) { sc0[j] = __shfl(mine, j, 16); sc1[j] = __shfl(mine, 4 + j, 16); } }
#pragma unroll
      for (int ai = 0; ai < 2; ++ai)
#pragma unroll
        for (int m = 0; m < 4; ++m) {
          const int hv = u.pm * 256 + ai * 128 + wr * 64 + m * 16 + fr;
          const int head = hv >> 7, dv = hv & 127;
          *(u32x4*)(VT + ((size_t)(b * 8 + head) * 128 + dv) * TP + pp0) = pack8(acc[ai][bj][m][0] * sc0, acc[ai][bj][m][1] * sc1);
        }
    }
  }
};

struct EpiOutA : EpiBase {
  DI void operator()(const f32x4 (&acc)[2][2][4][2], const pg8::Unit& u, int wr, int wc, int fr, int fq) const {
    bf16_t* H1B = (bf16_t*)(ws + OFF_H1B); float* ssq1 = (float*)(ws + OFF_SSQ1); const bf16_t* X0 = (const bf16_t*)(ws + OFF_XN0);
    const int rowb = u.pm * 256 + wr * 64 + fr, colb = u.pn * 256 + wc * 32 + 8 * fq;
#pragma unroll
    for (int ai = 0; ai < 2; ++ai) {
      u32x4 hb[4][2];
#pragma unroll
      for (int m = 0; m < 4; ++m)
#pragma unroll
        for (int bj = 0; bj < 2; ++bj) hb[m][bj] = *(const u32x4*)(X0 + (size_t)(rowb + ai * 128 + m * 16) * 1024 + colb + bj * 128);
#pragma unroll
      for (int m = 0; m < 4; ++m) {
        const int row = rowb + ai * 128 + m * 16;
#pragma unroll
        for (int bj = 0; bj < 2; ++bj) {
          const int col0 = colb + bj * 128;
          const u32x4 h = hb[m][bj];
          const f32x4 v0 = acc[ai][bj][m][0] + f32x4{bflo(h.x), bfhi(h.x), bflo(h.y), bfhi(h.y)}, v1 = acc[ai][bj][m][1] + f32x4{bflo(h.z), bfhi(h.z), bflo(h.w), bfhi(h.w)};
          *(u32x4*)(H1B + (size_t)row * 1024 + col0) = pack8(v0, v1);
          const float ss = quad_sum(sumsq8(v0, v1));
          if (fq == 0) ssq1[(size_t)row * 32 + (u.pn * 2 + bj) * 4 + wc] = ss;
        }
      }
    }
  }
};

struct EpiInB : EpiBase {
  DI void operator()(const f32x4 (&acc)[2][2][4][2], const pg8::Unit& u, int wr, int wc, int fr, int fq) const {
    const float* ssq1 = (const float*)(ws + OFF_SSQ1);
    bf16_t* dst = (bf16_t*)(ws + (u.pn < 4 ? OFF_U : OFF_GATEB));
    const bool gate = u.pn >= 4;
    const int rowb = u.pm * 256 + wr * 64 + fr;
    f32x4 t0[2][4], t1[2][4];
#pragma unroll
    for (int ai = 0; ai < 2; ++ai)
#pragma unroll
      for (int m = 0; m < 4; ++m) {
        const float* q = ssq1 + (size_t)(rowb + ai * 128 + m * 16) * 32 + 8 * fq;
        t0[ai][m] = ld4(q); t1[ai][m] = ld4(q + 4);
      }
    float sc[2][4];
#pragma unroll
    for (int ai = 0; ai < 2; ++ai)
#pragma unroll
      for (int m = 0; m < 4; ++m) {
        const f32x4 a = t0[ai][m], b = t1[ai][m];
        const float ss = quad_sum(((a[0] + a[1]) + (a[2] + a[3])) + ((b[0] + b[1]) + (b[2] + b[3])));
        sc[ai][m] = rsqrtf(ss * (1.f / 1024.f) + RMS_EPS);
      }
#pragma unroll
    for (int ai = 0; ai < 2; ++ai)
#pragma unroll
      for (int m = 0; m < 4; ++m) {
        const int row = rowb + ai * 128 + m * 16;
#pragma unroll
        for (int bj = 0; bj < 2; ++bj) {
          const int col0 = (u.pn & 3) * 256 + bj * 128 + wc * 32 + 8 * fq;
          f32x4 v0 = acc[ai][bj][m][0] * sc[ai][m], v1 = acc[ai][bj][m][1] * sc[ai][m];
          if (gate) { v0 = silu4(v0); v1 = silu4(v1); }
          *(u32x4*)(dst + (size_t)row * 1024 + col0) = pack8(v0, v1);
        }
      }
  }
};

struct EpiOutB : EpiBase {
  DI void operator()(const f32x4 (&acc)[2][2][4][2], const pg8::Unit& u, int wr, int wc, int fr, int fq) const {
    bf16_t* H2 = (bf16_t*)(ws + OFF_H1); const bf16_t* H1B = (const bf16_t*)(ws + OFF_H1B); float* ssq2 = (float*)(ws + OFF_SSQ2);
    const int rowb = u.pm * 256 + wr * 64 + fr, colb = u.pn * 256 + wc * 32 + 8 * fq;
#pragma unroll
    for (int ai = 0; ai < 2; ++ai) {
      u32x4 hb[4][2];
#pragma unroll
      for (int m = 0; m < 4; ++m)
#pragma unroll
        for (int bj = 0; bj < 2; ++bj) hb[m][bj] = *(const u32x4*)(H1B + (size_t)(rowb + ai * 128 + m * 16) * 1024 + colb + bj * 128);
#pragma unroll
      for (int m = 0; m < 4; ++m) {
        const int row = rowb + ai * 128 + m * 16;
#pragma unroll
        for (int bj = 0; bj < 2; ++bj) {
          const int col0 = colb + bj * 128;
          const u32x4 h = hb[m][bj];
          const f32x4 v0 = acc[ai][bj][m][0] + f32x4{bflo(h.x), bfhi(h.x), bflo(h.y), bfhi(h.y)}, v1 = acc[ai][bj][m][1] + f32x4{bflo(h.z), bfhi(h.z), bflo(h.w), bfhi(h.w)};
          *(u32x4*)(H2 + (size_t)row * 1024 + col0) = pack8(v0, v1);
          const float ss = quad_sum(sumsq8(v0, v1));
          if (fq == 0) ssq2[(size_t)row * 32 + (u.pn * 2 + bj) * 4 + wc] = ss;
        }
      }
    }
  }
};


DI void phase_uc(const Params& p) {
  char* ws = p.ws;
  const bf16_t* U = (const bf16_t*)(ws + OFF_U);
  bf16_t* UC = (bf16_t*)(ws + OFF_UC);
  const int total = (MP / 8) * 128;
  for (int e = blockIdx.x * NTHR + threadIdx.x; e < total; e += gridDim.x * NTHR) {
    const int cc = e & 127, rb8 = e >> 7;
    const int ch0 = cc * 8, r0 = rb8 * 8;
    f32x4 w0[4], w1[4];
#pragma unroll
    for (int j = 0; j < 4; ++j) { w0[j] = ld4(p.b_conv_w + j * 1024 + ch0); w1[j] = ld4(p.b_conv_w + j * 1024 + ch0 + 4); }
    const f32x4 b0 = ld4(p.b_conv_b + ch0), b1 = ld4(p.b_conv_b + ch0 + 4);
    u32x4 ur[11];
#pragma unroll
    for (int q = 0; q < 11; ++q) { int rr = r0 - 3 + q; rr = rr < 0 ? 0 : rr; ur[q] = *(const u32x4*)(U + (size_t)rr * 1024 + ch0); }
#pragma unroll
    for (int t = 0; t < 8; ++t) {
      f32x4 o0 = b0, o1 = b1;
#pragma unroll
      for (int j = 0; j < 4; ++j) {
        const u32x4 u = ur[t + j];
        o0 += w0[j] * f32x4{bflo(u.x), bfhi(u.x), bflo(u.y), bfhi(u.y)};
        o1 += w1[j] * f32x4{bflo(u.z), bfhi(u.z), bflo(u.w), bfhi(u.w)};
      }
      *(u32x4*)(UC + (size_t)(r0 + t) * 1024 + ch0) = pack8(o0, o1);
    }
  }
}


template <int SH> DI float row_shr(float v, float ident) {
  return __builtin_bit_cast(float, __builtin_amdgcn_update_dpp(__builtin_bit_cast(int, ident), __builtin_bit_cast(int, v), 0x110 + SH, 0xf, 0xf, false));
}
struct EpiRG : EpiBase {
  DI void operator()(const f32x4 (&acc)[2][2][4][2], const pg8::Unit& u, int wr, int wc, int fr, int fq) const {
    const int ch0 = u.pn * 128 + wc * 32 + 8 * fq;
    float brg[8], big[8], spl8[8];
    { const f32x4 a0 = ld4(p.b_b_rg + ch0), a1 = ld4(p.b_b_rg + ch0 + 4), c0 = ld4(p.b_b_ig + ch0), c1 = ld4(p.b_b_ig + ch0 + 4), l0 = ld4(p.b_lam + ch0), l1 = ld4(p.b_lam + ch0 + 4);
#pragma unroll
      for (int e = 0; e < 4; ++e) { brg[e] = a0[e]; brg[4 + e] = a1[e]; big[e] = c0[e]; big[4 + e] = c1[e]; spl8[e] = l0[e]; spl8[4 + e] = l1[e]; }
#pragma unroll
      for (int e = 0; e < 8; ++e) { const float lam = spl8[e], z = __expf(-lam);
        const float sp = lam < -20.f ? -lam : (z < 1e-2f ? z * (1.f - z * (0.5f - z * (1.f / 3.f))) : __logf(1.f + z));
        spl8[e] = -8.f * sp; } }
    const bf16_t* UC = (const bf16_t*)(ws + OFF_UC);
    bf16_t* HSL = (bf16_t*)(ws + OFF_HSL); bf16_t* PC = (bf16_t*)(ws + OFF_PCUM);
#pragma unroll
    for (int ai = 0; ai < 2; ++ai) {
      const int row0 = u.pm * 256 + ai * 128 + wr * 64;
      const int chunk = row0 >> 6, b = chunk / NCH, pp0 = row0 - b * TP;
      float ch_[8], cP[8];
#pragma unroll
      for (int e = 0; e < 8; ++e) { ch_[e] = 0.f; cP[e] = 1.f; }
      u32x4 ucl[4];
#pragma unroll
      for (int m = 0; m < 4; ++m) ucl[m] = *(const u32x4*)(UC + (size_t)(row0 + m * 16 + fr) * 1024 + ch0);
#pragma unroll
      for (int m = 0; m < 4; ++m) {
        const int row = row0 + m * 16 + fr, pp = pp0 + m * 16 + fr;
        const u32x4 ucv = ucl[m];
        f32x4 hv[2], Pv[2];
#pragma unroll
        for (int n = 0; n < 2; ++n)
#pragma unroll
          for (int j = 0; j < 4; ++j) {
            const int e = 4 * n + j;
            const unsigned uw = (e >> 1) == 0 ? ucv.x : (e >> 1) == 1 ? ucv.y : (e >> 1) == 2 ? ucv.z : ucv.w;
            const float uc = (e & 1) ? bfhi(uw) : bflo(uw);
            const float r = sigmoid_f(acc[ai][0][m][n][j] + brg[e]);
            const float ig = sigmoid_f(acc[ai][1][m][n][j] + big[e]);
            float a = __expf(spl8[e] * r);
            float mult = __builtin_amdgcn_sqrtf(fmaxf(1.f - a * a, 0.f));
            if (pp == PAD) mult = 1.f;
            float bb = mult * ig * uc;
            if (pp < PAD) { a = 1.f; bb = 0.f; }
            { const float ap = row_shr<1>(a, 1.f), bp = row_shr<1>(bb, 0.f); bb = a * bp + bb; a = a * ap; }
            { const float ap = row_shr<2>(a, 1.f), bp = row_shr<2>(bb, 0.f); bb = a * bp + bb; a = a * ap; }
            { const float ap = row_shr<4>(a, 1.f), bp = row_shr<4>(bb, 0.f); bb = a * bp + bb; a = a * ap; }
            { const float ap = row_shr<8>(a, 1.f), bp = row_shr<8>(bb, 0.f); bb = a * bp + bb; a = a * ap; }
            const float h = bb + a * ch_[e], P = a * cP[e];
            ch_[e] = __shfl(h, 15, 16); cP[e] = __shfl(P, 15, 16);
            hv[n][j] = h; Pv[n][j] = P;
          }
        *(u32x4*)(HSL + (size_t)row * 1024 + ch0) = pack8(hv[0], hv[1]);
        *(u32x4*)(PC + (size_t)row * 1024 + ch0) = pack8(Pv[0], Pv[1]);
      }
      if (fr == 0) {
        float* ca = (float*)(ws + OFF_CARA) + (size_t)chunk * 1024 + ch0;
        float* cb = (float*)(ws + OFF_CARB) + (size_t)chunk * 1024 + ch0;
        *(f32x4*)ca = f32x4{cP[0], cP[1], cP[2], cP[3]}; *(f32x4*)(ca + 4) = f32x4{cP[4], cP[5], cP[6], cP[7]};
        *(f32x4*)cb = f32x4{ch_[0], ch_[1], ch_[2], ch_[3]}; *(f32x4*)(cb + 4) = f32x4{ch_[4], ch_[5], ch_[6], ch_[7]};
      }
    }
  }
};

template <class Epi>
DI void gemm8(const Params& p, char* smem, size_t offA, int lda, int M, size_t offB, int ldb, int N, int K, int a_pn_bytes = 0) {
  pg8::Gemm g; g.a_pn_bytes = a_pn_bytes; g.A = (const bf16_t*)(p.ws + offA); g.Bt = (const bf16_t*)(p.ws + offB); g.M = M; g.N = N; g.K = K; g.lda = lda; g.ldb = ldb;
  pg8::StaticOrder S; S.init(M, N, gridDim.x, blockIdx.x);
  Epi E; E.ws = p.ws; E.p = p;
  pg8::gemm_phase<Epi, pg8::StaticOrder, false>((PG8_LAS unsigned char*)smem, g, S, E, nullptr);
}


struct EpiQKV { EpiQ q; EpiK k; EpiV v;
  DI void operator()(const f32x4 (&acc)[2][2][4][2], const pg8::MUnit& u, int wr, int wc, int fr, int fq) const {
    const pg8::Unit uu{u.pm, u.pn};
    if (u.gid == 0) q(acc, uu, wr, wc, fr, fq); else if (u.gid == 1) k(acc, uu, wr, wc, fr, fq); else v(acc, uu, wr, wc, fr, fq);
  }
};
struct QKVTraits {
  static constexpr pg8::CDesc d[3] = {
    {OFF_QLAT, OFF_WUQ, 640, 384, 6, MP / 256, 6, 0, -1, 0, 0, -1},
    {OFF_QLAT + 768, OFF_WK, 640, 256, 4, MP / 256, 4, 0, -1, 0, 0, -1},
    {OFF_WV, OFF_QLAT + 768, 256, 640, 4, 4, MP / 256, 0, -1, 0, 0, -1}};
};
template <class T, class Epi> DI void run_stream(const Params& p, char* smem, const Epi& E) {
  pg8::MultiOrder<T> S; S.ws = p.ws; S.G = gridDim.x; S.c = blockIdx.x; S.ready = (unsigned*)(p.ws + OFF_RDY); S.tmo = (unsigned*)(p.ws + OFF_BAR) + XB_TMO;
  pg8::gemm_stream<Epi, pg8::MultiOrder<T>>((PG8_LAS unsigned char*)smem, S, E);
}
DI void phase_qkv_stream(const Params& p, char* smem) {
  EpiQKV E; E.q.ws = p.ws; E.q.p = p; E.k.ws = p.ws; E.k.p = p; E.v.ws = p.ws; E.v.p = p;
  run_stream<QKVTraits>(p, smem, E);
}

constexpr int N_PHASES = 12;

__global__ void __launch_bounds__(512, 2) fwd_mega(Params p, int ph_lo, int ph_hi, int coop) {
  __shared__ __attribute__((aligned(16))) char smem[SMEM_BYTES];
  XcdBarrier xb;
  if (coop) {
    if (threadIdx.x < 4) { ((volatile unsigned*)(smem + 2 * HALF_BYTES))[threadIdx.x] = 0u; }
    __syncthreads();
    xb = xcd_barrier_post((unsigned*)(p.ws + OFF_BAR), (volatile LAS unsigned*)(smem + 2 * HALF_BYTES));
    if (coop == 2) cg::this_grid().sync();
  }
#ifndef ONLY_PHASE
#define ONLY_PHASE -1
#endif
#ifndef DUP_MASK
#define DUP_MASK 0
#endif
#define RUN_PHASE(k, call) if ((ONLY_PHASE < 0 || ONLY_PHASE == (k)) && ph_lo <= (k) && (k) < ph_hi) { call; if ((DUP_MASK >> (k)) & 1) { if (coop) xcd_barrier(xb); call; } if (coop && (k) + 1 < ph_hi) xcd_barrier(xb); }
  RUN_PHASE(0, phase_prep(p, smem))
  RUN_PHASE(1, gemm8<EpiG1>(p, smem, OFF_XN0, 1024, MP, OFF_WINA, 1024, 1792, 1024))
  RUN_PHASE(2, phase_qkv_stream(p, smem))
  RUN_PHASE(3, phase_attn(p, smem))
  RUN_PHASE(4, gemm8<EpiOutA>(p, smem, OFF_Y, 1024, MP, OFF_WOUTA, 1024, 1024, 1024))
  RUN_PHASE(5, gemm8<EpiInB>(p, smem, OFF_H1B, 1024, MP, OFF_WINB, 1024, 2048, 1024))
  RUN_PHASE(6, phase_uc(p))
  RUN_PHASE(7, gemm8<EpiRG>(p, smem, OFF_UC, 1024, MP, OFF_WRG, 256, 2048, 256, 512))
  RUN_PHASE(8, phase_rg2(p))
  RUN_PHASE(9, phase_rg3(p))
  RUN_PHASE(10, gemm8<EpiOutB>(p, smem, OFF_HSL, 1024, MP, OFF_WOUTB, 1024, 1024, 1024))
  RUN_PHASE(11, phase_final(p))
}

extern "C" void kernel_launch(void* const* d_in, const int* in_sizes, int n_in, void* d_out, int out_size, void* d_ws,
                              size_t ws_size, hipStream_t stream) {
  static int grid_blocks = 0;
  if (!grid_blocks) {
    int dev = 0, cus = 0, per_cu = 0;
    (void)hipGetDevice(&dev);
    (void)hipDeviceGetAttribute(&cus, hipDeviceAttributeMultiprocessorCount, dev);
    (void)hipOccupancyMaxActiveBlocksPerMultiprocessor(&per_cu, fwd_mega, NTHR, 0);
    if (per_cu > 1) per_cu = 1;
    if (per_cu < 1) per_cu = 1;
    grid_blocks = cus * per_cu;
  }
  if (ws_size < WS_NEEDED) { fprintf(stderr, "workspace too small: %zu < %zu\n", ws_size, (size_t)WS_NEEDED); return; }
  Params p{};
  p.x = (const float*)d_in[0]; p.meta = (const float*)d_in[1];
  p.a_norm_g = (const float*)d_in[2]; p.a_w_in = (const float*)d_in[3]; p.a_q_norm_g = (const float*)d_in[4];
  p.a_kv_norm_g = (const float*)d_in[5]; p.a_w_uq = (const float*)d_in[6]; p.a_w_ukv = (const float*)d_in[7];
  p.a_w_out = (const float*)d_in[8]; p.b_norm_g = (const float*)d_in[9]; p.b_w_in = (const float*)d_in[10];
  p.b_conv_w = (const float*)d_in[11]; p.b_conv_b = (const float*)d_in[12]; p.b_w_rg = (const float*)d_in[13];
  p.b_b_rg = (const float*)d_in[14]; p.b_w_ig = (const float*)d_in[15]; p.b_b_ig = (const float*)d_in[16];
  p.b_lam = (const float*)d_in[17]; p.b_w_out = (const float*)d_in[18]; p.final_norm_g = (const float*)d_in[19];
  p.out = (float*)d_out; p.ws = (char*)d_ws;
#if SINGLE_LAUNCH
  (void)hipMemsetAsync((char*)d_ws + OFF_BAR, 0, 16384 + RDY_BYTES, stream);
  int lo = 0, hi = N_PHASES, coop = 1;
  void* args[] = {&p, &lo, &hi, &coop};
  hipError_t e = hipLaunchCooperativeKernel((void*)fwd_mega, dim3(grid_blocks), dim3(NTHR), args, 0, stream);
  if (e != hipSuccess) fprintf(stderr, "cooperative launch failed: %s (grid %d)\n", hipGetErrorString(e), grid_blocks);
#else
  for (int ph = 0; ph < N_PHASES; ++ph) fwd_mega<<<grid_blocks, NTHR, 0, stream>>>(p, ph, ph + 1, 0);
#endif
}
```

```cpp
#include <hip/hip_runtime.h>
#include <hip/hip_cooperative_groups.h>
#include <cstdio>
#include <cstdint>
namespace cg = cooperative_groups;

#ifndef SINGLE_LAUNCH
#define SINGLE_LAUNCH 1
#endif

#define DI __device__ __forceinline__
typedef unsigned short bf16_t;
using bf16x8 = __attribute__((ext_vector_type(8))) short;
using f32x4  = __attribute__((ext_vector_type(4))) float;
using f32x16 = __attribute__((ext_vector_type(16))) float;
using u32x4 = __attribute__((ext_vector_type(4))) unsigned;
typedef __bf16 bf16v2 __attribute__((ext_vector_type(2)));

constexpr int NB = 8, SEQ = 4096, NMETA = 16;
constexpr int TP = 4224;
constexpr int PAD = 112;
constexpr int MP = NB * TP;
constexpr int NMT = MP / 128;
constexpr int DM = 1024;
constexpr int NTB = TP / 128;
constexpr int NCH = TP / 64;
constexpr float RMS_EPS = 1e-6f;
constexpr float QSCALE = 0.07216878364870322f * 1.4426950408889634f;

constexpr size_t SZ = (size_t)MP * 1024 * 2;
constexpr size_t OFF_XN0 = 0;
constexpr size_t OFF_Y = SZ;
constexpr size_t OFF_U = 0;
constexpr size_t OFF_QLAT = SZ;
constexpr size_t OFF_GATEB = SZ;
constexpr size_t OFF_GATEA = 2 * SZ;
constexpr size_t OFF_H1B = 3 * SZ;
constexpr size_t OFF_HSL = 2 * SZ;
constexpr size_t OFF_Q = 3 * SZ;
constexpr size_t OFF_KN = 4 * SZ + SZ / 2;
constexpr size_t OFF_VT = 5 * SZ + SZ / 2;
constexpr size_t OFF_H1 = 0;
constexpr size_t OFF_UC = 4 * SZ;
constexpr size_t OFF_PCUM = 5 * SZ;
constexpr size_t OFF_MISC = 6 * SZ + SZ / 2;
constexpr size_t OFF_KROPE = OFF_MISC;
constexpr size_t OFF_WINA = OFF_KROPE + (size_t)MP * 64 * 2;
constexpr size_t OFF_WUQ = OFF_WINA + (size_t)1792 * 1024 * 2;
constexpr size_t OFF_WUKV = OFF_WUQ + (size_t)1536 * 384 * 2;
constexpr size_t OFF_WK = OFF_WUKV;
constexpr size_t OFF_WV = OFF_WUKV + (size_t)1024 * 256 * 2;
constexpr size_t OFF_WOUTA = OFF_WUKV + (size_t)2048 * 256 * 2;
constexpr size_t OFF_WINB = OFF_WOUTA + (size_t)1024 * 1024 * 2;
constexpr size_t OFF_WRG = OFF_WINB + (size_t)2048 * 1024 * 2;
constexpr size_t OFF_WIG = OFF_WRG + (size_t)4 * 256 * 256 * 2;
constexpr size_t OFF_WOUTB = OFF_WIG + (size_t)4 * 256 * 256 * 2;
constexpr size_t OFF_RINV0 = OFF_WOUTB + (size_t)1024 * 1024 * 2;
constexpr size_t OFF_SSQA = OFF_RINV0 + (size_t)MP * 4;
constexpr size_t OFF_SSQ1 = OFF_SSQA + (size_t)MP * 32 * 4;
constexpr size_t OFF_SSQ2 = OFF_SSQ1 + (size_t)MP * 32 * 4;
constexpr size_t OFF_ROPEC = OFF_SSQ2 + (size_t)MP * 32 * 4;
constexpr size_t OFF_ROPES = OFF_ROPEC + (size_t)TP * 32 * 4;
constexpr size_t OFF_CARA = OFF_ROPES + (size_t)TP * 32 * 4;
constexpr size_t OFF_CARB = OFF_CARA + (size_t)NB * NCH * 1024 * 4;
constexpr size_t OFF_CARIN = OFF_CARB + (size_t)NB * NCH * 1024 * 4;
constexpr size_t OFF_BAR = OFF_CARIN + (size_t)NB * NCH * 1024 * 4;
constexpr size_t OFF_RDY = OFF_BAR + 16384;
constexpr size_t RDY_BYTES = 2 * 136 * 256;
constexpr size_t WS_NEEDED = OFF_RDY + RDY_BYTES;

struct Params {
  const float* x; const float* meta;
  const float* a_norm_g; const float* a_w_in; const float* a_q_norm_g; const float* a_kv_norm_g;
  const float* a_w_uq; const float* a_w_ukv; const float* a_w_out;
  const float* b_norm_g; const float* b_w_in; const float* b_conv_w; const float* b_conv_b;
  const float* b_w_rg; const float* b_b_rg; const float* b_w_ig; const float* b_b_ig;
  const float* b_lam; const float* b_w_out; const float* final_norm_g;
  float* out; char* ws;
};

DI unsigned pack2(float a, float b) { bf16v2 v = {(__bf16)a, (__bf16)b}; return __builtin_bit_cast(unsigned, v); }
DI bf16_t f2bf(float a) { __bf16 v = (__bf16)a; return __builtin_bit_cast(bf16_t, v); }
DI float bf2f(bf16_t v) { return __uint_as_float(((unsigned)v) << 16); }
DI float bflo(unsigned u) { return __uint_as_float(u << 16); }
DI float bfhi(unsigned u) { return __uint_as_float(u & 0xffff0000u); }
DI float sigmoid_f(float v) { return __builtin_amdgcn_rcpf(1.f + __expf(-v)); }
DI float silu_f(float v) { return v * sigmoid_f(v); }
DI u32x4 ldnt_u4(const void* q) { return __builtin_nontemporal_load((const u32x4*)q); }
DI f32x4 ldnt_f4(const void* q) { return __builtin_nontemporal_load((const f32x4*)q); }
DI f32x4 mfma16(bf16x8 a, bf16x8 b, f32x4 c) { return __builtin_amdgcn_mfma_f32_16x16x32_bf16(a, b, c, 0, 0, 0); }
DI f32x16 mfma32(bf16x8 a, bf16x8 b, f32x16 c) { return __builtin_amdgcn_mfma_f32_32x32x16_bf16(a, b, c, 0, 0, 0); }

#define XB_TMO      128
#define XB_XCNT(j)  (256  + 64 * (j))
#define XB_XSUB(j)  (1280 + 64 * (j))
#define XB_XGEN(j)  (2304 + 64 * (j))
#define XB_TOP      3328
#define XB_TOPGEN   3392
#define XCD_BAR_WORDS 3456
#define XB_SPIN_CAP (1u << 22)
#define LAS __attribute__((address_space(3)))
DI unsigned xb_ld(unsigned* p)              { return __hip_atomic_load(p, __ATOMIC_RELAXED, __HIP_MEMORY_SCOPE_AGENT); }
DI unsigned xb_add(unsigned* p, unsigned v) { return __hip_atomic_fetch_add(p, v, __ATOMIC_RELAXED, __HIP_MEMORY_SCOPE_AGENT); }
DI unsigned xb_xcc_id() { return (unsigned)__builtin_amdgcn_s_getreg((3 << 11) | 20) & 0xFu; }
#define XB_SPIN(cond, bar) do { unsigned _sp = 0; while (cond) { __builtin_amdgcn_s_sleep(1); \
    if ((++_sp & 255u) == 0u) { if (xb_ld(&(bar)[XB_TMO])) break; if (_sp > XB_SPIN_CAP) { atomicAdd(&(bar)[XB_TMO], 1u); break; } } } } while (0)
struct XcdBarrier { unsigned* bar; unsigned x; volatile LAS unsigned* st; };
DI XcdBarrier xcd_barrier_post(unsigned* bar, volatile LAS unsigned* st) {
  XcdBarrier b; b.bar = bar; b.x = xb_xcc_id(); b.st = st;
  if (threadIdx.x == 0) (void)xb_add(&bar[XB_XCNT(b.x)], 1u);
  return b;
}
DI void xcd_barrier_complete(unsigned* bar, unsigned x, unsigned& nloc, unsigned& nx) {
  const unsigned G = gridDim.x * gridDim.y * gridDim.z;
  unsigned sum, cnt, mine, sp = 0u;
  for (;;) {
    sum = 0u; cnt = 0u; mine = 0u;
#pragma unroll
    for (unsigned j = 0; j < 16; ++j) { const unsigned c = xb_ld(&bar[XB_XCNT(j)]); sum += c; cnt += (c > 0u) ? 1u : 0u; mine = (j == x) ? c : mine; }
    if (sum == G) break;
    __builtin_amdgcn_s_sleep(1);
    if ((++sp & 255u) == 0u) { if (xb_ld(&bar[XB_TMO])) break; if (sp > XB_SPIN_CAP) { atomicAdd(&bar[XB_TMO], 1u); break; } }
  }
  nloc = mine > 0u ? mine : 1u; nx = cnt > 0u ? cnt : 1u;
}
DI void xcd_barrier(const XcdBarrier& b) {
  asm volatile("s_waitcnt vmcnt(0)" ::: "memory");
  __syncthreads();
  if (threadIdx.x == 0) {
    unsigned* bar = b.bar;
    __builtin_amdgcn_s_waitcnt(0);
    unsigned nloc = b.st[0], nx = b.st[1];
    if (nloc == 0u) { xcd_barrier_complete(bar, b.x, nloc, nx); b.st[0] = nloc; b.st[1] = nx; }
    const unsigned old = xb_add(&bar[XB_XSUB(b.x)], 1u);
    const unsigned gen = old / nloc;
    if (old + 1u == (gen + 1u) * nloc) {
      __builtin_amdgcn_fence(__ATOMIC_RELEASE, "agent");
      asm volatile("s_waitcnt vmcnt(0)" ::: "memory");
      const unsigned og = xb_add(&bar[XB_TOP], 1u);
      const unsigned tg = og / nx;
      if (og + 1u == (tg + 1u) * nx) xb_add(&bar[XB_TOPGEN], 1u);
      else XB_SPIN(xb_ld(&bar[XB_TOPGEN]) == tg, bar);
      __builtin_amdgcn_fence(__ATOMIC_ACQUIRE, "agent");
      xb_add(&bar[XB_XGEN(b.x)], 1u);
      asm volatile("s_waitcnt vmcnt(0)" ::: "memory");
    } else {
      XB_SPIN(xb_ld(&bar[XB_XGEN(b.x)]) == gen, bar);
      __builtin_amdgcn_fence(__ATOMIC_ACQUIRE, "agent");
      asm volatile("s_waitcnt vmcnt(0)" ::: "memory");
    }
  }
  __syncthreads();
}

constexpr int SMEM_MAIN = 65536;
constexpr int SMEM_AGG = 2048;
constexpr int HALF_BYTES = SMEM_MAIN + SMEM_AGG;
constexpr int SMEM_BYTES = 2 * HALF_BYTES + 16;
constexpr int NTHR = 512;

DI void transpose_tile(const float* src, int ldsrc, int src_c0, int ncols_valid, bool ropeperm, const float* gscale, bf16_t* dst, int lddst,
                       int k0, int dst_n0, char* smem) {
  float* tile = (float*)smem;
  const int tid = threadIdx.x, tx = tid & 63, ty = tid >> 6;
  const int sc = ropeperm ? (32 * ((tx >> 2) & 1) + 16 * (tx >> 5) + 4 * ((tx >> 3) & 3) + (tx & 3)) : tx;
  __syncthreads();
  float v[16];
#pragma unroll
  for (int i = 0; i < 16; ++i) v[i] = (src_c0 + sc < ncols_valid) ? src[(size_t)(k0 + ty * 16 + i) * ldsrc + src_c0 + sc] : 0.f;
#pragma unroll
  for (int i = 0; i < 16; ++i) tile[(ty * 16 + i) * 65 + tx] = v[i];
  __syncthreads();
  const int kx = tid & 127, ny = tid >> 7;
  const float g = gscale ? gscale[k0 + kx] : 1.f;
#pragma unroll 4
  for (int i = 0; i < 16; ++i) {
    const int n = ny * 16 + i;
    dst[(size_t)(dst_n0 + n) * lddst + k0 + kx] = f2bf(tile[kx * 65 + n] * g);
  }
}

DI void phase_prep(const Params& p, char* smem) {
  char* ws = p.ws;
  const int tid = threadIdx.x, lane = tid & 63, wid = tid >> 6;
  constexpr int N_WINA = 8 * 28, N_WUQ = 3 * 24, N_WUKV = 2 * 32, N_WOUTA = 128, N_WINB = 8 * 32, N_WRG = 32, N_WIG = 32, N_WOUTB = 128;
  constexpr int T0 = N_WINA, T1 = T0 + N_WUQ, T2 = T1 + N_WUKV, T3 = T2 + N_WOUTA, T4 = T3 + N_WINB, T5 = T4 + N_WRG, T6 = T5 + N_WIG, T7 = T6 + N_WOUTB;
  constexpr int N_ROWS = MP / 8;
  constexpr int N_ROPE = TP * 32 / 512;
  constexpr int TOTAL = T7 + N_ROWS + N_ROPE;
  for (int it = blockIdx.x; it < TOTAL; it += gridDim.x) {
    if (it < T7) {
      if (it < T0)      { int t = it;      const int n0 = (t / 8) * 64; transpose_tile(p.a_w_in, 1728, n0, 1728, n0 == 640, p.a_norm_g, (bf16_t*)(ws + OFF_WINA), 1024, (t % 8) * 128, n0, smem); }
      else if (it < T1) { int t = it - T0; const int n0 = (t / 3) * 64; transpose_tile(p.a_w_uq, 1536, n0, 1536, ((n0 >> 6) % 3) == 2, p.a_q_norm_g, (bf16_t*)(ws + OFF_WUQ), 384, (t % 3) * 128, n0, smem); }
      else if (it < T2) { int t = it - T1; const int n0 = (t / 2) * 64;
                          const int h = n0 >> 8, d = n0 & 255;
                          bf16_t* dstw = (bf16_t*)(ws + (d < 128 ? OFF_WK : OFF_WV));
                          transpose_tile(p.a_w_ukv, 2048, n0, 2048, false, p.a_kv_norm_g, dstw, 256, (t % 2) * 128, h * 128 + (d & 127), smem); }
      else if (it < T3) { int t = it - T2; const int n0 = (t / 8) * 64; transpose_tile(p.a_w_out, 1024, n0, 1024, false, nullptr, (bf16_t*)(ws + OFF_WOUTA), 1024, (t % 8) * 128, n0, smem); }
      else if (it < T4) { int t = it - T3; const int n0 = (t / 8) * 64; transpose_tile(p.b_w_in, 2048, n0, 2048, false, p.b_norm_g, (bf16_t*)(ws + OFF_WINB), 1024, (t % 8) * 128, n0, smem); }
      else if (it < T6) { int t = it - T4; const int n0 = (t >> 1) * 64, k0 = (t & 1) * 128;
                          const int pn = n0 >> 8, hf = (n0 >> 7) & 1, ch0 = 128 * pn + (n0 & 127), g = ch0 >> 8, j0 = ch0 & 255;
                          transpose_tile((hf ? p.b_w_ig : p.b_w_rg) + g * 65536, 256, j0, 256, false, nullptr, (bf16_t*)(ws + OFF_WRG), 256, k0, n0, smem); }
      else              { int t = it - T6; const int n0 = (t / 8) * 64; transpose_tile(p.b_w_out, 1024, n0, 1024, false, nullptr, (bf16_t*)(ws + OFF_WOUTB), 1024, (t % 8) * 128, n0, smem); }
    } else if (it < T7 + N_ROWS) {
      const int row = (it - T7) * 8 + wid;
      const int b = row / TP, pp = row % TP;
      bf16_t* dst = (bf16_t*)(ws + OFF_XN0) + (size_t)row * DM;
      float* rinv0 = (float*)(ws + OFF_RINV0);
      if (pp < PAD) {
#pragma unroll
        for (int i = 0; i < 4; ++i) *(uint2*)(dst + i * 256 + lane * 4) = make_uint2(0u, 0u);
        if (lane == 0) rinv0[row] = 0.f;
      } else {
        const int pos = pp - PAD;
        const float* src = pos < NMETA ? p.meta + pos * DM : p.x + ((size_t)b * SEQ + (pos - NMETA)) * DM;
        float ss = 0.f;
        float4 v[4];
#pragma unroll
        for (int i = 0; i < 4; ++i) { const f32x4 t = ldnt_f4(src + i * 256 + lane * 4); v[i] = make_float4(t[0], t[1], t[2], t[3]); ss += v[i].x * v[i].x + v[i].y * v[i].y + v[i].z * v[i].z + v[i].w * v[i].w; }
#pragma unroll
        for (int o = 32; o >= 1; o >>= 1) ss += __shfl_xor(ss, o);
#pragma unroll
        for (int i = 0; i < 4; ++i) *(uint2*)(dst + i * 256 + lane * 4) = make_uint2(pack2(v[i].x, v[i].y), pack2(v[i].z, v[i].w));
        if (lane == 0) rinv0[row] = rsqrtf(ss * (1.f / 1024.f) + RMS_EPS);
      }
    } else {
      const int e = (it - T7 - N_ROWS) * 512 + tid;
      const int pp = e >> 5, i = e & 31;
      const float inv_freq = __builtin_amdgcn_exp2f(-(float)i * (13.287712379549449f / 32.f));
      const float ang = (float)(pp - PAD) * inv_freq;
      const double rev = (double)ang * 0.15915494309189535;
      const float fr_ = (float)(rev - rint(rev));
      const float s = __builtin_amdgcn_sinf(fr_), c = __builtin_amdgcn_cosf(fr_);
      ((float*)(ws + OFF_ROPEC))[e] = c;
      ((float*)(ws + OFF_ROPES))[e] = s;
    }
  }
}

DI int koff(int key, int ch) { return key * 384 + (((ch & ~7) | ((ch ^ (key >> 1)) & 7)) << 4); }
DI int voff(int dv, int ch) { return dv * 128 + ((ch ^ ((dv >> 1) & 7)) << 4); }

DI void attn_item(const Params& p, int b, int h, int j, char* smem) {
  char* ws = p.ws;
  const int tid = threadIdx.x, lane = tid & 63, w = tid >> 6;
  const int r = lane & 31, hh = lane >> 5;
  const int wq0 = 256 * j - 128 + 32 * w;
  const bool wactive = (wq0 + 31 >= PAD);
  const int q_pp = wq0 + r;
  const int bh = b * 8 + h;
  bf16x8 qf[12];
  if (wactive) {
    const bf16_t* Qp = (const bf16_t*)(ws + OFF_Q) + ((size_t)bh * TP + q_pp) * 192 + hh * 8;
#pragma unroll
    for (int ks = 0; ks < 12; ++ks) qf[ks] = *(const bf16x8*)(Qp + ks * 16);
  } else {
#pragma unroll
    for (int ks = 0; ks < 12; ++ks) qf[ks] = bf16x8{0, 0, 0, 0, 0, 0, 0, 0};
  }
  f32x16 o[4];
#pragma unroll
  for (int d = 0; d < 4; ++d)
#pragma unroll
    for (int i = 0; i < 16; ++i) o[d][i] = 0.f;
  float m_i = -INFINITY, l_i = 0.f;
  const bf16_t* KNb = (const bf16_t*)(ws + OFF_KN) + (size_t)bh * TP * 128;
  const bf16_t* KRb = (const bf16_t*)(ws + OFF_KROPE) + (size_t)b * TP * 64;
  const bf16_t* VTb = (const bf16_t*)(ws + OFF_VT) + (size_t)bh * 128 * TP;
  const int pir = (r & 19) | ((r & 4) << 1) | ((r & 8) >> 1);
  const int nlast = 4 * j + 1;
  const int kn_key = tid >> 4, kn_ch = tid & 15;
  const int kr_key = tid >> 3, kr_ch = tid & 7;
  const int v_dv = tid >> 3, v_ch = tid & 7;
  u32x4 st0, st1, st2, st3, st4;
#define ATT_LOAD(kt) do { \
    st0 = *(const u32x4*)(KNb + (size_t)((kt) * 64 + kn_key) * 128 + kn_ch * 8); \
    st1 = *(const u32x4*)(KNb + (size_t)((kt) * 64 + 32 + kn_key) * 128 + kn_ch * 8); \
    st2 = *(const u32x4*)(KRb + (size_t)((kt) * 64 + kr_key) * 64 + kr_ch * 8); \
    st3 = *(const u32x4*)(VTb + (size_t)v_dv * TP + (kt) * 64 + v_ch * 8); \
    st4 = *(const u32x4*)(VTb + (size_t)(v_dv + 64) * TP + (kt) * 64 + v_ch * 8); } while (0)
#define ATT_STORE(buf) do { char* Kd = smem + (buf) * 40960; char* Vd = Kd + 24576; \
    *(u32x4*)(Kd + koff(kn_key, kn_ch)) = st0; *(u32x4*)(Kd + koff(32 + kn_key, kn_ch)) = st1; \
    *(u32x4*)(Kd + koff(kr_key, 16 + kr_ch)) = st2; \
    *(u32x4*)(Vd + voff(v_dv, v_ch)) = st3; *(u32x4*)(Vd + voff(v_dv + 64, v_ch)) = st4; } while (0)
  __syncthreads();
  int kb[4], vb[4];
#pragma unroll
  for (int q = 0; q < 4; ++q) {
    kb[q] = pir * 384 + ((((2 * q + hh) ^ (pir >> 1)) & 7) << 4);
    vb[q] = r * 128 + ((((2 * q + hh) ^ (r >> 1)) & 7) << 4);
  }
  const int grp = w >> 2;
  ATT_LOAD(1);
  ATT_STORE(1);
  if (nlast >= 2) ATT_LOAD(2);
  __syncthreads();
  if (grp == 1) __builtin_amdgcn_s_barrier();
  for (int kt = 1; kt <= nlast; ++kt) {
    const char* Ks = smem + (kt & 1) * 40960; const char* Vs = Ks + 24576;
    const int kmin = kt * 64;
    const bool work = wactive && kmin <= wq0 + 31;
    f32x16 s0, s1;
#pragma unroll
    for (int i = 0; i < 16; ++i) { s0[i] = 0.f; s1[i] = 0.f; }
    if (work) {
      __builtin_amdgcn_s_setprio(1);
#pragma unroll
      for (int ks = 0; ks < 12; ++ks) {
        const bf16x8 a0 = *(const bf16x8*)(Ks + kb[ks & 3] + (ks >> 2) * 128);
        const bf16x8 a1 = *(const bf16x8*)(Ks + kb[ks & 3] + (ks >> 2) * 128 + 32 * 384);
        s0 = mfma32(a0, qf[ks], s0);
        s1 = mfma32(a1, qf[ks], s1);
      }
      __builtin_amdgcn_s_setprio(0);
    }
    if (grp == 1 && kt < nlast) { ATT_STORE((kt + 1) & 1); if (kt + 2 <= nlast) ATT_LOAD(kt + 2); }
    __syncthreads();
    if (work) {
      if (kt == 1 || kmin + 63 > wq0) {
#pragma unroll
        for (int i = 0; i < 16; ++i) {
          const int kl = (i & 3) + 4 * ((i >> 2) & 1) + 8 * hh + 16 * ((i >> 3) & 1);
          const int k0 = kmin + kl, k1 = kmin + 32 + kl;
          if (!(k0 <= q_pp && k0 >= PAD)) s0[i] = -1e30f;
          if (!(k1 <= q_pp && k1 >= PAD)) s1[i] = -1e30f;
        }
      }
      float mx = s0[0];
#pragma unroll
      for (int i = 1; i < 16; ++i) mx = fmaxf(mx, s0[i]);
#pragma unroll
      for (int i = 0; i < 16; ++i) mx = fmaxf(mx, s1[i]);
      mx = fmaxf(mx, __shfl_xor(mx, 32));
      if (!__all(mx - m_i <= 6.f)) {
        const float m_new = fmaxf(m_i, mx);
        const float alpha = __builtin_amdgcn_exp2f(m_i - m_new);
        m_i = m_new;
        l_i *= alpha;
#pragma unroll
        for (int d = 0; d < 4; ++d)
#pragma unroll
          for (int i = 0; i < 16; ++i) o[d][i] *= alpha;
      }
      float rsum = 0.f;
#pragma unroll
      for (int i = 0; i < 16; ++i) { s0[i] = __builtin_amdgcn_exp2f(s0[i] - m_i); rsum += s0[i]; }
#pragma unroll
      for (int i = 0; i < 16; ++i) { s1[i] = __builtin_amdgcn_exp2f(s1[i] - m_i); rsum += s1[i]; }
      l_i += rsum;
#pragma unroll
      for (int t2 = 0; t2 < 2; ++t2)
#pragma unroll
        for (int sp = 0; sp < 2; ++sp) {
          const f32x16& sx = t2 ? s1 : s0;
          const uint4 pk = make_uint4(pack2(sx[8 * sp + 0], sx[8 * sp + 1]), pack2(sx[8 * sp + 2], sx[8 * sp + 3]),
                                      pack2(sx[8 * sp + 4], sx[8 * sp + 5]), pack2(sx[8 * sp + 6], sx[8 * sp + 7]));
          const bf16x8 pf = __builtin_bit_cast(bf16x8, pk);
#pragma unroll
          for (int d = 0; d < 4; ++d) {
            const bf16x8 vf = *(const bf16x8*)(Vs + vb[2 * t2 + sp] + d * 4096);
            o[d] = mfma32(vf, pf, o[d]);
          }
        }
    }
    if (grp == 0 && kt < nlast) { ATT_STORE((kt + 1) & 1); if (kt + 2 <= nlast) ATT_LOAD(kt + 2); }
    __syncthreads();
  }
  if (grp == 0) __builtin_amdgcn_s_barrier();
#undef ATT_LOAD
#undef ATT_STORE
  if (wactive) {
    const float ltot = l_i + __shfl_xor(l_i, 32);
    const float inv = __builtin_amdgcn_rcpf(ltot);
    const size_t row = (size_t)b * TP + q_pp;
    const bf16_t* ga = (const bf16_t*)(ws + OFF_GATEA) + row * 1024 + h * 128;
    bf16_t* y = (bf16_t*)(ws + OFF_Y) + row * 1024 + h * 128;
    uint2 gvs[4][4];
#pragma unroll
    for (int d = 0; d < 4; ++d)
#pragma unroll
      for (int g4 = 0; g4 < 4; ++g4) gvs[d][g4] = *(const uint2*)(ga + d * 32 + 8 * g4 + 4 * hh);
#pragma unroll
    for (int d = 0; d < 4; ++d)
#pragma unroll
      for (int g4 = 0; g4 < 4; ++g4) {
        const int dv0 = d * 32 + 8 * g4 + 4 * hh;
        const uint2 gv = gvs[d][g4];
        const float y0 = o[d][4 * g4 + 0] * inv * bflo(gv.x), y1 = o[d][4 * g4 + 1] * inv * bfhi(gv.x);
        const float y2 = o[d][4 * g4 + 2] * inv * bflo(gv.y), y3 = o[d][4 * g4 + 3] * inv * bfhi(gv.y);
        *(uint2*)(y + dv0) = make_uint2(pack2(y0, y1), pack2(y2, y3));
      }
  }
}

DI void phase_attn(const Params& p, char* smem) {
  constexpr int NQT = 17;
  constexpr int total = NB * 8 * NQT;
  const int G = gridDim.x;
  for (int rd = 0; rd * G < total; ++rd) {
    const int it = rd * G + ((rd & 1) ? (G - 1 - (int)blockIdx.x) : (int)blockIdx.x);
    if (it >= total) continue;
    const int j = NQT - 1 - it / 64, bh = it % 64;
    attn_item(p, bh >> 3, bh & 7, j, smem);
  }
}

DI void phase_rg2(const Params& p) {
  char* ws = p.ws;
  const int gt = blockIdx.x * NTHR + threadIdx.x;
  if (gt < NB * 1024) {
    const int b = gt >> 10, ch = gt & 1023;
    const float* CA = (const float*)(ws + OFF_CARA) + (size_t)b * NCH * 1024 + ch;
    const float* CB = (const float*)(ws + OFF_CARB) + (size_t)b * NCH * 1024 + ch;
    float* CI = (float*)(ws + OFF_CARIN) + (size_t)b * NCH * 1024 + ch;
    float c = 0.f;
#pragma unroll 1
    for (int j0 = 0; j0 < NCH; j0 += 22) {
      float a[22], bb[22];
#pragma unroll
      for (int k = 0; k < 22; ++k) { a[k] = CA[(j0 + k) * 1024]; bb[k] = CB[(j0 + k) * 1024]; }
#pragma unroll
      for (int k = 0; k < 22; ++k) { CI[(j0 + k) * 1024] = c; c = a[k] * c + bb[k]; }
    }
  }
}

DI void phase_rg3(const Params& p) {
  char* ws = p.ws;
  const size_t total = (size_t)MP * 128;
  bf16_t* HSL = (bf16_t*)(ws + OFF_HSL);
  const bf16_t* PC = (const bf16_t*)(ws + OFF_PCUM);
  const bf16_t* GB = (const bf16_t*)(ws + OFF_GATEB);
  const float* CI = (const float*)(ws + OFF_CARIN);
  for (size_t e = (size_t)blockIdx.x * NTHR + threadIdx.x; e < total; e += (size_t)gridDim.x * NTHR) {
    const int row = (int)(e >> 7), c8 = (int)(e & 127) * 8;
    const int j = row >> 6;
    const u32x4 hv_ = ldnt_u4(HSL + (size_t)row * 1024 + c8); const uint4 hv = make_uint4(hv_.x, hv_.y, hv_.z, hv_.w);
    const u32x4 pv_ = ldnt_u4(PC + (size_t)row * 1024 + c8); const uint4 pv = make_uint4(pv_.x, pv_.y, pv_.z, pv_.w);
    const u32x4 gv_ = ldnt_u4(GB + (size_t)row * 1024 + c8); const uint4 gv = make_uint4(gv_.x, gv_.y, gv_.z, gv_.w);
    const float4 c0 = *(const float4*)(CI + (size_t)j * 1024 + c8), c1 = *(const float4*)(CI + (size_t)j * 1024 + c8 + 4);
    uint4 ov;
    ov.x = pack2((bflo(hv.x) + bflo(pv.x) * c0.x) * bflo(gv.x), (bfhi(hv.x) + bfhi(pv.x) * c0.y) * bfhi(gv.x));
    ov.y = pack2((bflo(hv.y) + bflo(pv.y) * c0.z) * bflo(gv.y), (bfhi(hv.y) + bfhi(pv.y) * c0.w) * bfhi(gv.y));
    ov.z = pack2((bflo(hv.z) + bflo(pv.z) * c1.x) * bflo(gv.z), (bfhi(hv.z) + bfhi(pv.z) * c1.y) * bfhi(gv.z));
    ov.w = pack2((bflo(hv.w) + bflo(pv.w) * c1.z) * bflo(gv.w), (bfhi(hv.w) + bfhi(pv.w) * c1.w) * bfhi(gv.w));
    *(uint4*)(HSL + (size_t)row * 1024 + c8) = ov;
  }
}

DI void phase_final(const Params& p) {
  char* ws = p.ws;
  const int lane = threadIdx.x & 63, wid = threadIdx.x >> 6;
  const bf16_t* H = (const bf16_t*)(ws + OFF_H1);
  const float* ssq2 = (const float*)(ws + OFF_SSQ2);
  for (int it = blockIdx.x; it < NB * SEQ / 8; it += gridDim.x) {
    const int orow = it * 8 + wid;
    const int b = orow >> 12, s = orow & 4095;
    const int row = b * TP + PAD + NMETA + s;
    float ss = 0.f;
    { const float v = (lane < 32) ? ssq2[(size_t)row * 32 + lane] : 0.f; ss = v; }
    uint4 hv[2];
#pragma unroll
    for (int i = 0; i < 2; ++i) { const u32x4 t = ldnt_u4(H + (size_t)row * 1024 + i * 512 + lane * 8); hv[i] = make_uint4(t.x, t.y, t.z, t.w); }
#pragma unroll
    for (int o = 16; o >= 1; o >>= 1) ss += __shfl_xor(ss, o);
    ss = __shfl(ss, 0);
    const float sc = rsqrtf(ss * (1.f / 1024.f) + RMS_EPS);
#pragma unroll
    for (int i = 0; i < 2; ++i) {
      const int col = i * 512 + lane * 8;
      const float4 g0 = *(const float4*)(p.final_norm_g + col), g1 = *(const float4*)(p.final_norm_g + col + 4);
      const uint4 h = hv[i];
      *(float4*)(p.out + (size_t)orow * 1024 + col) = make_float4(bflo(h.x) * sc * g0.x, bfhi(h.x) * sc * g0.y, bflo(h.y) * sc * g0.z, bfhi(h.y) * sc * g0.w);
      *(float4*)(p.out + (size_t)orow * 1024 + col + 4) = make_float4(bflo(h.z) * sc * g1.x, bfhi(h.z) * sc * g1.y, bflo(h.w) * sc * g1.z, bfhi(h.w) * sc * g1.w);
    }
  }
}

namespace pg8 {
#define PG8_LAS __attribute__((address_space(3)))
typedef unsigned short bf16_t;
typedef short bf16x8 __attribute__((ext_vector_type(8)));
typedef float f32x4 __attribute__((ext_vector_type(4)));
typedef unsigned u32x4 __attribute__((ext_vector_type(4)));
constexpr int BM = 256, BK = 64, HALF = 128, HTB = HALF * BK * 2  , STAGE_BYTES = 8 * HTB, NXCD = 8, WGM = 8;

__host__ __device__ __forceinline__ int lds_byte(int r, int c) { const int st = (r >> 4) * 2 + (c >> 5), rr = r & 15, cc = c & 31, ob = rr * 64 + cc * 2; return st * 1024 + (ob ^ (((ob >> 9) & 1) << 5)); }
__host__ __device__ __forceinline__ void stage_rc(int b, int& R, int& C) { const int st = b / 1024, sb = b % 1024, swz = sb ^ (((sb >> 9) & 1) << 5); R = (st >> 1) * 16 + swz / 64; C = (st & 1) * 32 + (swz % 64) / 2; }
__host__ __device__ __forceinline__ int perm32(int rho) { const int n = rho >> 4, i = rho & 15; return 8 * (i >> 2) + 4 * n + (i & 3); }
struct Unit { int pm, pn; };
struct Gemm { const bf16_t* A; const bf16_t* Bt; int M, N, K, lda, ldb, a_pn_bytes; };

struct StaticOrder {
    int nM, nN, nwg, G, c;
    __host__ __device__ void init(int M, int N, int G_, int c_) { nM = M / BM; nN = N / BM; nwg = nM * nN; G = G_; c = c_; }
    __host__ __device__ bool next(int i, Unit& u) const {
        const long L = (long)i * G + c; if (L >= nwg) return false;
        int wgid = (int)L; { const int q = nwg / NXCD, r = nwg % NXCD, xcd = wgid % NXCD, off = wgid / NXCD; wgid = (xcd < r ? xcd * (q + 1) : r * (q + 1) + (xcd - r) * q) + off; }
        const int nig = WGM * nN, gid = wgid / nig, fm = gid * WGM, gsz = (nM - fm) < WGM ? (nM - fm) : WGM;
        u.pm = fm + ((wgid % nig) % gsz); u.pn = (wgid % nig) / gsz; return true;
    }
    __device__ __forceinline__ void a_ready(const Unit&) const {}
    __device__ __forceinline__ void done(const Unit&) const {}
};
template <class Epi, class Sched, bool STAMP = false>
__device__ __forceinline__ void gemm_phase(PG8_LAS unsigned char* lds, const Gemm g, const Sched& S, const Epi& E, unsigned long long* stamps) {
    int tid_ = threadIdx.x; asm volatile("" : "+v"(tid_));
    const int tid = tid_, wid = __builtin_amdgcn_readfirstlane(tid >> 6), lane = tid & 63, wr = wid >> 2, wc = wid & 3, fr = lane & 15, fq = lane >> 4;
    const int K = g.K, nt = K / BK;
    int ts_lo = 0, ts_hi = 0, nts = 0; const unsigned long long rt_entry = STAMP ? (unsigned long long)wall_clock64() : 0ull;
#define PG8_STAMP() do { if (STAMP && wid == 0 && nts < 64) { const unsigned long long _c = (unsigned long long)clock64(); \
        ts_lo = (lane == nts) ? (int)(unsigned)_c : ts_lo; ts_hi = (lane == nts) ? (int)(unsigned)(_c >> 32) : ts_hi; ++nts; } } while (0)
    PG8_STAMP();
    unsigned voffA[2], voffB[2];
#pragma unroll
    for (int i = 0; i < 2; ++i) { int R, C; stage_rc(tid * 16 + i * 8192, R, C); const int Rb = Epi::PERM ? ((R & ~31) + perm32(R & 31)) : R;
        voffA[i] = (unsigned)(R * g.lda + C) * 2u; voffB[i] = (unsigned)(Rb * g.ldb + C) * 2u; }
    const size_t kstep = (size_t)(BK * 2);
    const size_t hstepA = (size_t)HALF * g.lda * 2, hstepB = (size_t)HALF * g.ldb * 2;
    const size_t tstepA = 2 * hstepA, tstepB = 2 * hstepB;
    const unsigned ldsw = (unsigned)wid * 1024u;
    const int aoff = lds_byte(wr * 64 + fr, fq * 8), boff = lds_byte(wc * 32 + fr, fq * 8);
#define PG8_SA(b, h) (((b) * 2 + (h)) * HTB)
#define PG8_SB(b, h) ((4 + (b) * 2 + (h)) * HTB)
#define PG8_STAGE(bufoff, gbase, voff) do { _Pragma("unroll") for (int _i = 0; _i < 2; ++_i) \
        __builtin_amdgcn_global_load_lds((const unsigned*)((const char*)(gbase) + (voff)[_i]), (PG8_LAS unsigned*)(lds + (bufoff) + ldsw + _i * 8192), 16, 0, 0); } while (0)
#define PG8_LDA(dst, b, h) do { _Pragma("unroll") for (int m = 0; m < 4; ++m) _Pragma("unroll") for (int k = 0; k < 2; ++k) dst[m][k] = *(const PG8_LAS bf16x8*)(lds + PG8_SA(b, h) + aoff + m * 2048 + k * 1024); } while (0)
#define PG8_LDB(dst, b, h) do { _Pragma("unroll") for (int n = 0; n < 2; ++n) _Pragma("unroll") for (int k = 0; k < 2; ++k) dst[n][k] = *(const PG8_LAS bf16x8*)(lds + PG8_SB(b, h) + boff + n * 2048 + k * 1024); } while (0)
#define PG8_MMA(ai, bj, At, Bt) do { __builtin_amdgcn_s_setprio(1); _Pragma("unroll") for (int m = 0; m < 4; ++m) _Pragma("unroll") for (int n = 0; n < 2; ++n) _Pragma("unroll") for (int k = 0; k < 2; ++k) \
        acc[ai][bj][m][n] = __builtin_amdgcn_mfma_f32_16x16x32_bf16(Bt[n][k], At[m][k], acc[ai][bj][m][n], 0, 0, 0); __builtin_amdgcn_s_setprio(0); } while (0)
#define PG8_WAIT_V(n) asm volatile("s_waitcnt vmcnt(" #n ")" ::: "memory")
#define PG8_WAIT_L(n) asm volatile("s_waitcnt lgkmcnt(" #n ")" ::: "memory")
#define PG8_BAR __builtin_amdgcn_s_barrier()
#define PG8_SCHED __builtin_amdgcn_sched_barrier(0)
    Unit cur, nxt; int ui = 0;
    if (!S.next(0, cur)) return;
    f32x4 acc[2][2][4][2];
#pragma unroll
    for (int a = 0; a < 2; ++a)
#pragma unroll
        for (int b = 0; b < 2; ++b)
#pragma unroll
            for (int m = 0; m < 4; ++m)
#pragma unroll
                for (int n = 0; n < 2; ++n) acc[a][b][m][n] = (f32x4){0.f, 0.f, 0.f, 0.f};
    bf16x8 At[4][2], B0[2][2], B1[2][2];
    const char* cA = (const char*)g.A + (size_t)cur.pm * tstepA + (size_t)(cur.pn >> 1) * g.a_pn_bytes; const char* cB = (const char*)g.Bt + (size_t)cur.pn * tstepB;
    S.a_ready(cur);
    PG8_STAGE(PG8_SB(0, 0), cB, voffB); PG8_STAGE(PG8_SA(0, 0), cA, voffA); PG8_STAGE(PG8_SB(0, 1), cB + hstepB, voffB); PG8_STAGE(PG8_SA(0, 1), cA + hstepA, voffA);
    if (wr == 1) PG8_BAR;
    PG8_WAIT_V(4); PG8_BAR;
    PG8_STAGE(PG8_SB(1, 0), cB + kstep, voffB); PG8_STAGE(PG8_SA(1, 0), cA + kstep, voffA); PG8_STAGE(PG8_SB(1, 1), cB + hstepB + kstep, voffB);
    PG8_WAIT_V(6); PG8_BAR;
    PG8_STAMP();
    for (;;) {
        const bool has_next = S.next(ui + 1, nxt);
        const char* nA = has_next ? (const char*)g.A + (size_t)nxt.pm * tstepA + (size_t)(nxt.pn >> 1) * g.a_pn_bytes : cA; const char* nB = has_next ? (const char*)g.Bt + (size_t)nxt.pn * tstepB : cB;
#pragma unroll 1
        for (int t = 0; t < nt; t += 2) {
            const bool last = (t == nt - 2);
            const char* a1 = cA + (size_t)(t + 1) * kstep;
            const char* a2 = last ? nA : cA + (size_t)(t + 2) * kstep; const char* b2 = last ? nB : cB + (size_t)(t + 2) * kstep;
            const char* a3 = a2 + kstep; const char* b3 = b2 + kstep;
            if (last && has_next) S.a_ready(nxt);
            PG8_LDB(B0, 0, 0); PG8_SCHED; PG8_LDA(At, 0, 0); PG8_STAGE(PG8_SA(1, 1), a1 + hstepA, voffA);
            PG8_WAIT_L(8); PG8_BAR; PG8_WAIT_L(0); PG8_MMA(0, 0, At, B0); PG8_BAR; PG8_SCHED;
            PG8_LDB(B1, 0, 1); PG8_STAGE(PG8_SB(0, 0), b2, voffB);
            PG8_BAR; PG8_WAIT_L(0); PG8_MMA(0, 1, At, B1); PG8_BAR;
            PG8_LDA(At, 0, 1); PG8_STAGE(PG8_SA(0, 0), a2, voffA);
            PG8_BAR; PG8_WAIT_L(0); PG8_MMA(1, 0, At, B0); PG8_BAR; PG8_SCHED;
            PG8_STAGE(PG8_SB(0, 1), b2 + hstepB, voffB);
            PG8_WAIT_V(6); PG8_BAR; PG8_MMA(1, 1, At, B1); PG8_BAR;
            PG8_LDB(B0, 1, 0); PG8_SCHED; PG8_LDA(At, 1, 0); PG8_STAGE(PG8_SA(0, 1), a2 + hstepA, voffA);
            PG8_WAIT_L(8); PG8_BAR; PG8_WAIT_L(0); PG8_MMA(0, 0, At, B0); PG8_BAR; PG8_SCHED;
            PG8_LDB(B1, 1, 1); PG8_STAGE(PG8_SB(1, 0), b3, voffB);
            PG8_BAR; PG8_WAIT_L(0); PG8_MMA(0, 1, At, B1); PG8_BAR;
            PG8_LDA(At, 1, 1); PG8_STAGE(PG8_SA(1, 0), a3, voffA);
            PG8_BAR; PG8_WAIT_L(0); PG8_MMA(1, 0, At, B0); PG8_BAR; PG8_SCHED;
            PG8_STAGE(PG8_SB(1, 1), b3 + hstepB, voffB);
            PG8_WAIT_V(6); PG8_BAR; PG8_MMA(1, 1, At, B1); PG8_BAR;
        }
        PG8_STAMP();
        if constexpr (!Epi::AFTER_DRAIN) { E(acc, cur, wr, wc, fr, fq); S.done(cur); }
        PG8_STAMP();
        if (!has_next) break;
#pragma unroll
        for (int a = 0; a < 2; ++a)
#pragma unroll
            for (int b = 0; b < 2; ++b)
#pragma unroll
                for (int m = 0; m < 4; ++m)
#pragma unroll
                    for (int n = 0; n < 2; ++n) acc[a][b][m][n] = (f32x4){0.f, 0.f, 0.f, 0.f};
        cur = nxt; cA = nA; cB = nB; ++ui;
    }
    PG8_WAIT_V(0);
    if (wr == 0) PG8_BAR;
    PG8_BAR;
    if constexpr (Epi::AFTER_DRAIN) { E.fused(acc, cur, wr, wc, fr, fq, lds, wid, lane); S.done(cur); }
    PG8_STAMP();
    if (STAMP && wid == 0) { stamps[lane] = lane < nts ? (((unsigned long long)(unsigned)ts_hi << 32) | (unsigned)ts_lo) : 0ull;
        if (lane == 62) stamps[62] = rt_entry; if (lane == 63) stamps[63] = (unsigned long long)wall_clock64(); }
#undef PG8_STAMP
#undef PG8_SA
#undef PG8_SB
#undef PG8_STAGE
#undef PG8_LDA
#undef PG8_LDB
#undef PG8_MMA
#undef PG8_WAIT_V
#undef PG8_WAIT_L
#undef PG8_BAR
#undef PG8_SCHED
}
}


namespace pg8 {
struct GDesc { const bf16_t* A; const bf16_t* Bt; int lda, ldb, nt, nM, nN, a_pn_bytes, dep, dep_need, dep_on_b, pub; };
struct MUnit { int pm, pn, gid; };
constexpr int RDY_PANELS = 136;
struct CDesc { size_t offA, offB; int lda, ldb, nt, nM, nN, a_pn_bytes, dep, dep_need, dep_on_b, pub; };
template <class T> struct MultiOrder {
  char* ws; int G, c; unsigned* ready; unsigned* tmo;
  static constexpr int off1 = T::d[0].nM * T::d[0].nN, off2 = off1 + T::d[1].nM * T::d[1].nN, off3 = off2 + T::d[2].nM * T::d[2].nN;
  __device__ __forceinline__ GDesc desc(int gid) const {
    GDesc r;
#define PG8_SEL(f) (gid == 0 ? T::d[0].f : (gid == 1 ? T::d[1].f : T::d[2].f))
    r.A = (const bf16_t*)(ws + PG8_SEL(offA)); r.Bt = (const bf16_t*)(ws + PG8_SEL(offB));
    r.lda = PG8_SEL(lda); r.ldb = PG8_SEL(ldb); r.nt = PG8_SEL(nt); r.nM = PG8_SEL(nM); r.nN = PG8_SEL(nN); r.a_pn_bytes = PG8_SEL(a_pn_bytes);
    r.dep = PG8_SEL(dep); r.dep_need = PG8_SEL(dep_need); r.dep_on_b = PG8_SEL(dep_on_b); r.pub = PG8_SEL(pub);
#undef PG8_SEL
    return r;
  }
  __device__ __forceinline__ bool next(int i, MUnit& u) const {
    const int L = i * G + c; if (L >= off3) return false;
    const int gid = L < off1 ? 0 : (L < off2 ? 1 : 2);
    const int base = gid == 0 ? 0 : (gid == 1 ? off1 : off2);
    const int nM = gid == 0 ? T::d[0].nM : (gid == 1 ? T::d[1].nM : T::d[2].nM), nN = gid == 0 ? T::d[0].nN : (gid == 1 ? T::d[1].nN : T::d[2].nN);
    int wgid = L - base; const int nwg = nM * nN;
    { const int q = nwg / NXCD, r = nwg % NXCD, xcd = wgid % NXCD, o = wgid / NXCD; wgid = (xcd < r ? xcd * (q + 1) : r * (q + 1) + (xcd - r) * q) + o; }
    const int nig = WGM * nN, grp = wgid / nig, fm = grp * WGM, gsz = (nM - fm) < WGM ? (nM - fm) : WGM;
    u.pm = fm + ((wgid % nig) % gsz); u.pn = (wgid % nig) / gsz; u.gid = gid; return true;
  }
  __device__ __forceinline__ void a_ready(const MUnit& u) const {
    const GDesc g = desc(u.gid);
    if (g.dep < 0) return;
    if (threadIdx.x < 64) {
      const unsigned* w = ready + (size_t)(g.dep * RDY_PANELS + (g.dep_on_b ? u.pn : u.pm)) * 64;
      const unsigned long long t0 = __builtin_amdgcn_s_memrealtime(); unsigned polls = 0;
      while ((unsigned)__builtin_amdgcn_readfirstlane(__hip_atomic_load(w, __ATOMIC_RELAXED, __HIP_MEMORY_SCOPE_AGENT)) < (unsigned)g.dep_need) {
        if ((++polls & 255u) == 0u && __builtin_amdgcn_readfirstlane(__hip_atomic_load(tmo, __ATOMIC_RELAXED, __HIP_MEMORY_SCOPE_AGENT)) != 0u) break;
        if (__builtin_amdgcn_s_memrealtime() - t0 > 2000000ull) { if (threadIdx.x == 0) __hip_atomic_store(tmo, 1u, __ATOMIC_RELAXED, __HIP_MEMORY_SCOPE_AGENT); break; }
        __builtin_amdgcn_s_sleep(2); }
      __builtin_amdgcn_fence(__ATOMIC_ACQUIRE, "agent");
      asm volatile("s_waitcnt vmcnt(0)" ::: "memory");
    }
    asm volatile("" ::: "memory"); __builtin_amdgcn_s_barrier(); asm volatile("" ::: "memory");
  }
  __device__ __forceinline__ void done(const MUnit& u) const {
    const GDesc g = desc(u.gid);
    if (g.pub < 0) return;
    asm volatile("s_waitcnt vmcnt(0)" ::: "memory");
    __builtin_amdgcn_fence(__ATOMIC_RELEASE, "agent");
    asm volatile("s_waitcnt vmcnt(0)" ::: "memory");
    if ((threadIdx.x & 63) == 0) __hip_atomic_fetch_add(ready + (size_t)(g.pub * RDY_PANELS + u.pm) * 64, 1u, __ATOMIC_RELAXED, __HIP_MEMORY_SCOPE_AGENT);
  }
};

template <class Epi, class Sched>
__device__ __forceinline__ void gemm_stream(PG8_LAS unsigned char* lds, const Sched& S, const Epi& E) {
    int tid_ = threadIdx.x; asm volatile("" : "+v"(tid_));
    const int tid = tid_, wid = __builtin_amdgcn_readfirstlane(tid >> 6), lane = tid & 63, wr = wid >> 2, wc = wid & 3, fr = lane & 15, fq = lane >> 4;
    int sR0, sR1, sB0, sB1, sC0, sC1;
    { int R, C; stage_rc(tid * 16, R, C); sR0 = R; sC0 = C * 2; sB0 = (R & ~31) + perm32(R & 31);
      stage_rc(tid * 16 + 8192, R, C); sR1 = R; sC1 = C * 2; sB1 = (R & ~31) + perm32(R & 31); }
    const int kstep = BK * 2;
    const unsigned ldsw = (unsigned)wid * 1024u;
    const int aoff = lds_byte(wr * 64 + fr, fq * 8), boff = lds_byte(wc * 32 + fr, fq * 8);
#define PG8_SA(b, h) (((b) * 2 + (h)) * HTB)
#define PG8_SB(b, h) ((4 + (b) * 2 + (h)) * HTB)
#define PG8_STAGE2(bufoff, gbase, r0, r1, ld2) do { \
        __builtin_amdgcn_global_load_lds((const unsigned*)((const char*)(gbase) + (unsigned)((r0) * (ld2) + sC0)), (PG8_LAS unsigned*)(lds + (bufoff) + ldsw), 16, 0, 0); \
        __builtin_amdgcn_global_load_lds((const unsigned*)((const char*)(gbase) + (unsigned)((r1) * (ld2) + sC1)), (PG8_LAS unsigned*)(lds + (bufoff) + ldsw + 8192), 16, 0, 0); } while (0)
#define PG8_STA(bufoff, gbase, ld2) PG8_STAGE2(bufoff, gbase, sR0, sR1, ld2)
#define PG8_STB(bufoff, gbase, ld2) PG8_STAGE2(bufoff, gbase, sB0, sB1, ld2)
#define PG8_LDA(dst, b, h) do { _Pragma("unroll") for (int m = 0; m < 4; ++m) _Pragma("unroll") for (int k = 0; k < 2; ++k) dst[m][k] = *(const PG8_LAS bf16x8*)(lds + PG8_SA(b, h) + aoff + m * 2048 + k * 1024); } while (0)
#define PG8_LDB(dst, b, h) do { _Pragma("unroll") for (int n = 0; n < 2; ++n) _Pragma("unroll") for (int k = 0; k < 2; ++k) dst[n][k] = *(const PG8_LAS bf16x8*)(lds + PG8_SB(b, h) + boff + n * 2048 + k * 1024); } while (0)
#define PG8_MMA(ai, bj, At, Bt) do { __builtin_amdgcn_s_setprio(1); _Pragma("unroll") for (int m = 0; m < 4; ++m) _Pragma("unroll") for (int n = 0; n < 2; ++n) _Pragma("unroll") for (int k = 0; k < 2; ++k) \
        acc[ai][bj][m][n] = __builtin_amdgcn_mfma_f32_16x16x32_bf16(Bt[n][k], At[m][k], acc[ai][bj][m][n], 0, 0, 0); __builtin_amdgcn_s_setprio(0); } while (0)
#define PG8_WAIT_V(n) asm volatile("s_waitcnt vmcnt(" #n ")" ::: "memory")
#define PG8_WAIT_L(n) asm volatile("s_waitcnt lgkmcnt(" #n ")" ::: "memory")
#define PG8_BAR __builtin_amdgcn_s_barrier()
#define PG8_SCHED __builtin_amdgcn_sched_barrier(0)
    MUnit cur, nxt; int ui = 0;
    if (!S.next(0, cur)) return;
    f32x4 acc[2][2][4][2];
#pragma unroll
    for (int a = 0; a < 2; ++a)
#pragma unroll
        for (int b = 0; b < 2; ++b)
#pragma unroll
            for (int m = 0; m < 4; ++m)
#pragma unroll
                for (int n = 0; n < 2; ++n) acc[a][b][m][n] = (f32x4){0.f, 0.f, 0.f, 0.f};
    bf16x8 At[4][2], B0[2][2], B1[2][2];
    GDesc gc = S.desc(cur.gid);
    int la2 = gc.lda * 2, lb2 = gc.ldb * 2;
    int hA = HALF * gc.lda * 2, hB = HALF * gc.ldb * 2;
    int nt = gc.nt;
    const char* cA = (const char*)gc.A + (size_t)cur.pm * 2 * hA + (size_t)(cur.pn >> 1) * gc.a_pn_bytes; const char* cB = (const char*)gc.Bt + (size_t)cur.pn * 2 * hB;
    S.a_ready(cur);
    PG8_STB(PG8_SB(0, 0), cB, lb2); PG8_STA(PG8_SA(0, 0), cA, la2); PG8_STB(PG8_SB(0, 1), cB + hB, lb2); PG8_STA(PG8_SA(0, 1), cA + hA, la2);
    if (wr == 1) PG8_BAR;
    PG8_WAIT_V(4); PG8_BAR;
    PG8_STB(PG8_SB(1, 0), cB + kstep, lb2); PG8_STA(PG8_SA(1, 0), cA + kstep, la2); PG8_STB(PG8_SB(1, 1), cB + hB + kstep, lb2);
    PG8_WAIT_V(6); PG8_BAR;
    for (;;) {
        const bool has_next = S.next(ui + 1, nxt);
        GDesc gn = gc; if (has_next) gn = S.desc(nxt.gid);
        const int nla2 = gn.lda * 2, nlb2 = gn.ldb * 2;
        const int nhA = HALF * gn.lda * 2, nhB = HALF * gn.ldb * 2;
        const char* nA = has_next ? (const char*)gn.A + (size_t)nxt.pm * 2 * nhA + (size_t)(nxt.pn >> 1) * gn.a_pn_bytes : cA;
        const char* nB = has_next ? (const char*)gn.Bt + (size_t)nxt.pn * 2 * nhB : cB;
#pragma unroll 1
        for (int t = 0; t < nt; t += 2) {
            const bool last = (t == nt - 2);
            const char* a1 = cA + (t + 1) * kstep;
            const char* a2 = last ? nA : cA + (t + 2) * kstep; const char* b2 = last ? nB : cB + (t + 2) * kstep;
            const char* a3 = a2 + kstep; const char* b3 = b2 + kstep;
            const int xla2 = last ? nla2 : la2, xlb2 = last ? nlb2 : lb2;
            const int xhA = last ? nhA : hA, xhB = last ? nhB : hB;
            if (last && has_next) S.a_ready(nxt);
            PG8_LDB(B0, 0, 0); PG8_SCHED; PG8_LDA(At, 0, 0); PG8_STA(PG8_SA(1, 1), a1 + hA, la2);
            PG8_WAIT_L(8); PG8_BAR; PG8_WAIT_L(0); PG8_MMA(0, 0, At, B0); PG8_BAR; PG8_SCHED;
            PG8_LDB(B1, 0, 1); PG8_STB(PG8_SB(0, 0), b2, xlb2);
            PG8_BAR; PG8_WAIT_L(0); PG8_MMA(0, 1, At, B1); PG8_BAR;
            PG8_LDA(At, 0, 1); PG8_STA(PG8_SA(0, 0), a2, xla2);
            PG8_BAR; PG8_WAIT_L(0); PG8_MMA(1, 0, At, B0); PG8_BAR; PG8_SCHED;
            PG8_STB(PG8_SB(0, 1), b2 + xhB, xlb2);
            PG8_WAIT_V(6); PG8_BAR; PG8_MMA(1, 1, At, B1); PG8_BAR;
            PG8_LDB(B0, 1, 0); PG8_SCHED; PG8_LDA(At, 1, 0); PG8_STA(PG8_SA(0, 1), a2 + xhA, xla2);
            PG8_WAIT_L(8); PG8_BAR; PG8_WAIT_L(0); PG8_MMA(0, 0, At, B0); PG8_BAR; PG8_SCHED;
            PG8_LDB(B1, 1, 1); PG8_STB(PG8_SB(1, 0), b3, xlb2);
            PG8_BAR; PG8_WAIT_L(0); PG8_MMA(0, 1, At, B1); PG8_BAR;
            PG8_LDA(At, 1, 1); PG8_STA(PG8_SA(1, 0), a3, xla2);
            PG8_BAR; PG8_WAIT_L(0); PG8_MMA(1, 0, At, B0); PG8_BAR; PG8_SCHED;
            PG8_STB(PG8_SB(1, 1), b3 + xhB, xlb2);
            PG8_WAIT_V(6); PG8_BAR; PG8_MMA(1, 1, At, B1); PG8_BAR;
        }
        { int fr_ = fr, fq_ = fq; asm volatile("" : "+v"(fr_), "+v"(fq_));
          E(acc, cur, wr, wc, fr_, fq_); }
        S.done(cur);
        if (!has_next) break;
#pragma unroll
        for (int a = 0; a < 2; ++a)
#pragma unroll
            for (int b = 0; b < 2; ++b)
#pragma unroll
                for (int m = 0; m < 4; ++m)
#pragma unroll
                    for (int n = 0; n < 2; ++n) acc[a][b][m][n] = (f32x4){0.f, 0.f, 0.f, 0.f};
        cur = nxt; cA = nA; cB = nB; la2 = nla2; lb2 = nlb2; hA = nhA; hB = nhB; nt = gn.nt; gc = gn; ++ui;
    }
    PG8_WAIT_V(0);
    if (wr == 0) PG8_BAR;
    PG8_BAR;
#undef PG8_SA
#undef PG8_SB
#undef PG8_STAGE2
#undef PG8_STA
#undef PG8_STB
#undef PG8_LDA
#undef PG8_LDB
#undef PG8_MMA
#undef PG8_WAIT_V
#undef PG8_WAIT_L
#undef PG8_BAR
#undef PG8_SCHED
}
}

struct EpiBase { static constexpr bool PERM = true, AFTER_DRAIN = false; char* ws; Params p; };
DI float quad_sum(float v) { v += __shfl_xor(v, 16); v += __shfl_xor(v, 32); return v; }
DI u32x4 pack8(const f32x4& a, const f32x4& b) { u32x4 w; w.x = pack2(a[0], a[1]); w.y = pack2(a[2], a[3]); w.z = pack2(b[0], b[1]); w.w = pack2(b[2], b[3]); return w; }
DI float sumsq8(const f32x4& a, const f32x4& b) { return a[0]*a[0] + a[1]*a[1] + a[2]*a[2] + a[3]*a[3] + b[0]*b[0] + b[1]*b[1] + b[2]*b[2] + b[3]*b[3]; }
DI f32x4 silu4(const f32x4& a) { f32x4 r; r[0] = silu_f(a[0]); r[1] = silu_f(a[1]); r[2] = silu_f(a[2]); r[3] = silu_f(a[3]); return r; }
DI f32x4 ld4(const float* q) { return *(const f32x4*)q; }

struct EpiG1 : EpiBase {
  DI void operator()(const f32x4 (&acc)[2][2][4][2], const pg8::Unit& u, int wr, int wc, int fr, int fq) const {
    const float* rinv0 = (const float*)(ws + OFF_RINV0);
    bf16_t* ql = (bf16_t*)(ws + OFF_QLAT); float* ssqa = (float*)(ws + OFF_SSQA);
    bf16_t* kr = (bf16_t*)(ws + OFF_KROPE); bf16_t* ga = (bf16_t*)(ws + OFF_GATEA);
    const float* rc = (const float*)(ws + OFF_ROPEC); const float* rsn = (const float*)(ws + OFF_ROPES);
    const int rowb = u.pm * 256 + wr * 64 + fr;
    float rsv[2][4];
#pragma unroll
    for (int ai = 0; ai < 2; ++ai)
#pragma unroll
      for (int m = 0; m < 4; ++m) rsv[ai][m] = rinv0[rowb + ai * 128 + m * 16];
    const bool ropeu = (u.pn == 2) && (wc < 2);
    const int ri = 16 * wc + 4 * fq;
    const int b0 = (u.pm * 256) / TP;
#pragma unroll
    for (int ai = 0; ai < 2; ++ai) {
#pragma unroll
      for (int mp = 0; mp < 2; ++mp) {
      f32x4 cs[2], sns[2];
      if (ropeu) {
#pragma unroll
        for (int mm = 0; mm < 2; ++mm) {
          const int row = rowb + ai * 128 + (2 * mp + mm) * 16;
          const int pp = row - (b0 + (row >= (b0 + 1) * TP ? 1 : 0)) * TP;
          cs[mm] = ld4(rc + pp * 32 + ri); sns[mm] = ld4(rsn + pp * 32 + ri);
        }
      }
#pragma unroll
      for (int mm = 0; mm < 2; ++mm) {
        const int m = 2 * mp + mm;
        const int row = rowb + ai * 128 + m * 16;
        const float rs = rsv[ai][m];
#pragma unroll
        for (int bj = 0; bj < 2; ++bj) {
          const int unit = u.pn * 2 + bj;
          const f32x4 v0 = acc[ai][bj][m][0] * rs, v1 = acc[ai][bj][m][1] * rs;
          if (unit < 5) {
            *(u32x4*)(ql + (size_t)row * 640 + unit * 128 + wc * 32 + 8 * fq) = pack8(v0, v1);
            const float ss = quad_sum(sumsq8(v0, v1));
            if (fq == 0) ssqa[(size_t)row * 32 + unit * 4 + wc] = ss;
          } else if (unit == 5 && wc < 2) {
            const int i = ri;
            const f32x4 c = cs[mm], sn = sns[mm];
            const f32x4 o1 = v0 * c - v1 * sn, o2 = v0 * sn + v1 * c;
            *(uint2*)(kr + (size_t)row * 64 + i) = make_uint2(pack2(o1[0], o1[1]), pack2(o1[2], o1[3]));
            *(uint2*)(kr + (size_t)row * 64 + 32 + i) = make_uint2(pack2(o2[0], o2[1]), pack2(o2[2], o2[3]));
          } else {
            const int gc = unit * 128 + wc * 32 + 8 * fq - 704;
            if (gc < 1024) *(u32x4*)(ga + (size_t)row * 1024 + gc) = pack8(silu4(v0), silu4(v1));
          }
        }
      }
      }
    }
  }
};

struct EpiQ : EpiBase {
  DI void operator()(const f32x4 (&acc)[2][2][4][2], const pg8::Unit& u, int wr, int wc, int fr, int fq) const {
    const float* ssqa = (const float*)(ws + OFF_SSQA);
    const float* rc = (const float*)(ws + OFF_ROPEC); const float* rsn = (const float*)(ws + OFF_ROPES);
    bf16_t* Q = (bf16_t*)(ws + OFF_Q);
    float scv[2][4];
    { float2 tq[2][4]; float tr[2][4];
#pragma unroll
      for (int ai = 0; ai < 2; ++ai)
#pragma unroll
        for (int m = 0; m < 4; ++m) { const float* q = ssqa + (size_t)(u.pm * 256 + ai * 128 + wr * 64 + m * 16 + fr) * 32; tq[ai][m] = *(const float2*)(q + 2 * fq); tr[ai][m] = q[8 + fq]; }
#pragma unroll
      for (int ai = 0; ai < 2; ++ai)
#pragma unroll
        for (int m = 0; m < 4; ++m) scv[ai][m] = rsqrtf(quad_sum(tq[ai][m].x + tq[ai][m].y + tr[ai][m]) * (1.f / 384.f) + RMS_EPS) * QSCALE; }
    const int slab0 = (u.pn * 2) * 2 + (wc >> 1), slab1 = slab0 + 2;
    const bool rope0 = (slab0 % 3) == 2, rope1 = (slab1 % 3) == 2;
    const int ri = 16 * (wc & 1) + 4 * fq;
    const int b0 = (u.pm * 256) / TP;
#pragma unroll
    for (int ai = 0; ai < 2; ++ai) {
      f32x4 cs[4], sns[4];
      if (rope0 || rope1) {
#pragma unroll
        for (int m = 0; m < 4; ++m) {
          const int row = u.pm * 256 + ai * 128 + wr * 64 + m * 16 + fr;
          const int pp = row - (b0 + (row >= (b0 + 1) * TP ? 1 : 0)) * TP;
          cs[m] = ld4(rc + pp * 32 + ri); sns[m] = ld4(rsn + pp * 32 + ri);
        }
      }
#pragma unroll
      for (int m = 0; m < 4; ++m) {
        const int row = u.pm * 256 + ai * 128 + wr * 64 + m * 16 + fr;
        const int b = b0 + (row >= (b0 + 1) * TP ? 1 : 0), pp = row - b * TP;
        const float sc = scv[ai][m];
#pragma unroll
        for (int bj = 0; bj < 2; ++bj) {
          const int slab = bj ? slab1 : slab0;
          const int head = slab / 3, part = slab % 3;
          bf16_t* qrow = Q + ((size_t)(b * 8 + head) * TP + pp) * 192;
          const f32x4 v0 = acc[ai][bj][m][0] * sc, v1 = acc[ai][bj][m][1] * sc;
          if (part < 2) {
            *(u32x4*)(qrow + part * 64 + (wc & 1) * 32 + 8 * fq) = pack8(v0, v1);
          } else {
            const f32x4 c = cs[m], sn = sns[m];
            const f32x4 o1 = v0 * c - v1 * sn, o2 = v0 * sn + v1 * c;
            *(uint2*)(qrow + 128 + ri) = make_uint2(pack2(o1[0], o1[1]), pack2(o1[2], o1[3]));
            *(uint2*)(qrow + 160 + ri) = make_uint2(pack2(o2[0], o2[1]), pack2(o2[2], o2[3]));
          }
        }
      }
    }
  }
};

DI float kv_scale(const float* ssqa, int row) {
  const f32x4 s0 = ld4(ssqa + (size_t)row * 32 + 12), s1 = ld4(ssqa + (size_t)row * 32 + 16);
  return rsqrtf(((s0[0] + s0[1] + s0[2] + s0[3]) + (s1[0] + s1[1] + s1[2] + s1[3])) * (1.f / 256.f) + RMS_EPS);
}

struct EpiK : EpiBase {
  DI void operator()(const f32x4 (&acc)[2][2][4][2], const pg8::Unit& u, int wr, int wc, int fr, int fq) const {
    const float* ssqa = (const float*)(ws + OFF_SSQA);
    bf16_t* KN = (bf16_t*)(ws + OFF_KN);
    float scv[2][4];
    { float2 tq[2][4];
#pragma unroll
      for (int ai = 0; ai < 2; ++ai)
#pragma unroll
        for (int m = 0; m < 4; ++m) tq[ai][m] = *(const float2*)(ssqa + (size_t)(u.pm * 256 + ai * 128 + wr * 64 + m * 16 + fr) * 32 + 12 + 2 * fq);
#pragma unroll
      for (int ai = 0; ai < 2; ++ai)
#pragma unroll
        for (int m = 0; m < 4; ++m) scv[ai][m] = rsqrtf(quad_sum(tq[ai][m].x + tq[ai][m].y) * (1.f / 256.f) + RMS_EPS); }
#pragma unroll
    for (int ai = 0; ai < 2; ++ai)
#pragma unroll
      for (int m = 0; m < 4; ++m) {
        const int row = u.pm * 256 + ai * 128 + wr * 64 + m * 16 + fr;
        const int b0 = (u.pm * 256) / TP, b = b0 + (row >= (b0 + 1) * TP ? 1 : 0), pp = row - b * TP;
        const float sc = scv[ai][m];
#pragma unroll
        for (int bj = 0; bj < 2; ++bj) {
          const int head = u.pn * 2 + bj;
          *(u32x4*)(KN + ((size_t)(b * 8 + head) * TP + pp) * 128 + wc * 32 + 8 * fq) = pack8(acc[ai][bj][m][0] * sc, acc[ai][bj][m][1] * sc);
        }
      }
  }
};

struct EpiV : EpiBase {
  DI void operator()(const f32x4 (&acc)[2][2][4][2], const pg8::Unit& u, int wr, int wc, int fr, int fq) const {
    const float* ssqa = (const float*)(ws + OFF_SSQA);
    bf16_t* VT = (bf16_t*)(ws + OFF_VT);
#pragma unroll
    for (int bj = 0; bj < 2; ++bj) {
      const int tok0 = u.pn * 256 + bj * 128 + wc * 32 + 8 * fq;
      const int b0 = (u.pn * 256) / TP, b = b0 + (tok0 >= (b0 + 1) * TP ? 1 : 0), pp0 = tok0 - b * TP;
      f32x4 sc0, sc1;
      { const float mine = kv_scale(ssqa, tok0 + (fr & 7));
#pragma unroll
        for (int j = 0; j < 4; ++j) { sc0[j] = __shfl(mine, j, 16); sc1[j] = __shfl(mine, 4 + j, 16); } }
#pragma unroll
      for (int ai = 0; ai < 2; ++ai)
#pragma unroll
        for (int m = 0; m < 4; ++m) {
          const int hv = u.pm * 256 + ai * 128 + wr * 64 + m * 16 + fr;
          const int head = hv >> 7, dv = hv & 127;
          *(u32x4*)(VT + ((size_t)(b * 8 + head) * 128 + dv) * TP + pp0) = pack8(acc[ai][bj][m][0] * sc0, acc[ai][bj][m][1] * sc1);
        }
    }
  }
};

struct EpiOutA : EpiBase {
  DI void operator()(const f32x4 (&acc)[2][2][4][2], const pg8::Unit& u, int wr, int wc, int fr, int fq) const {
    bf16_t* H1B = (bf16_t*)(ws + OFF_H1B); float* ssq1 = (float*)(ws + OFF_SSQ1); const bf16_t* X0 = (const bf16_t*)(ws + OFF_XN0);
    const int rowb = u.pm * 256 + wr * 64 + fr, colb = u.pn * 256 + wc * 32 + 8 * fq;
#pragma unroll
    for (int ai = 0; ai < 2; ++ai) {
      u32x4 hb[4][2];
#pragma unroll
      for (int m = 0; m < 4; ++m)
#pragma unroll
        for (int bj = 0; bj < 2; ++bj) hb[m][bj] = *(const u32x4*)(X0 + (size_t)(rowb + ai * 128 + m * 16) * 1024 + colb + bj * 128);
#pragma unroll
      for (int m = 0; m < 4; ++m) {
        const int row = rowb + ai * 128 + m * 16;
#pragma unroll
        for (int bj = 0; bj < 2; ++bj) {
          const int col0 = colb + bj * 128;
          const u32x4 h = hb[m][bj];
          const f32x4 v0 = acc[ai][bj][m][0] + f32x4{bflo(h.x), bfhi(h.x), bflo(h.y), bfhi(h.y)}, v1 = acc[ai][bj][m][1] + f32x4{bflo(h.z), bfhi(h.z), bflo(h.w), bfhi(h.w)};
          *(u32x4*)(H1B + (size_t)row * 1024 + col0) = pack8(v0, v1);
          const float ss = quad_sum(sumsq8(v0, v1));
          if (fq == 0) ssq1[(size_t)row * 32 + (u.pn * 2 + bj) * 4 + wc] = ss;
        }
      }
    }
  }
};

struct EpiInB : EpiBase {
  DI void operator()(const f32x4 (&acc)[2][2][4][2], const pg8::Unit& u, int wr, int wc, int fr, int fq) const {
    const float* ssq1 = (const float*)(ws + OFF_SSQ1);
    bf16_t* dst = (bf16_t*)(ws + (u.pn < 4 ? OFF_U : OFF_GATEB));
    const bool gate = u.pn >= 4;
    const int rowb = u.pm * 256 + wr * 64 + fr;
    f32x4 t0[2][4], t1[2][4];
#pragma unroll
    for (int ai = 0; ai < 2; ++ai)
#pragma unroll
      for (int m = 0; m < 4; ++m) {
        const float* q = ssq1 + (size_t)(rowb + ai * 128 + m * 16) * 32 + 8 * fq;
        t0[ai][m] = ld4(q); t1[ai][m] = ld4(q + 4);
      }
    float sc[2][4];
#pragma unroll
    for (int ai = 0; ai < 2; ++ai)
#pragma unroll
      for (int m = 0; m < 4; ++m) {
        const f32x4 a = t0[ai][m], b = t1[ai][m];
        const float ss = quad_sum(((a[0] + a[1]) + (a[2] + a[3])) + ((b[0] + b[1]) + (b[2] + b[3])));
        sc[ai][m] = rsqrtf(ss * (1.f / 1024.f) + RMS_EPS);
      }
#pragma unroll
    for (int ai = 0; ai < 2; ++ai)
#pragma unroll
      for (int m = 0; m < 4; ++m) {
        const int row = rowb + ai * 128 + m * 16;
#pragma unroll
        for (int bj = 0; bj < 2; ++bj) {
          const int col0 = (u.pn & 3) * 256 + bj * 128 + wc * 32 + 8 * fq;
          f32x4 v0 = acc[ai][bj][m][0] * sc[ai][m], v1 = acc[ai][bj][m][1] * sc[ai][m];
          if (gate) { v0 = silu4(v0); v1 = silu4(v1); }
          *(u32x4*)(dst + (size_t)row * 1024 + col0) = pack8(v0, v1);
        }
      }
  }
};

struct EpiOutB : EpiBase {
  DI void operator()(const f32x4 (&acc)[2][2][4][2], const pg8::Unit& u, int wr, int wc, int fr, int fq) const {
    bf16_t* H2 = (bf16_t*)(ws + OFF_H1); const bf16_t* H1B = (const bf16_t*)(ws + OFF_H1B); float* ssq2 = (float*)(ws + OFF_SSQ2);
    const int rowb = u.pm * 256 + wr * 64 + fr, colb = u.pn * 256 + wc * 32 + 8 * fq;
#pragma unroll
    for (int ai = 0; ai < 2; ++ai) {
      u32x4 hb[4][2];
#pragma unroll
      for (int m = 0; m < 4; ++m)
#pragma unroll
        for (int bj = 0; bj < 2; ++bj) hb[m][bj] = *(const u32x4*)(H1B + (size_t)(rowb + ai * 128 + m * 16) * 1024 + colb + bj * 128);
#pragma unroll
      for (int m = 0; m < 4; ++m) {
        const int row = rowb + ai * 128 + m * 16;
#pragma unroll
        for (int bj = 0; bj < 2; ++bj) {
          const int col0 = colb + bj * 128;
          const u32x4 h = hb[m][bj];
          const f32x4 v0 = acc[ai][bj][m][0] + f32x4{bflo(h.x), bfhi(h.x), bflo(h.y), bfhi(h.y)}, v1 = acc[ai][bj][m][1] + f32x4{bflo(h.z), bfhi(h.z), bflo(h.w), bfhi(h.w)};
          *(u32x4*)(H2 + (size_t)row * 1024 + col0) = pack8(v0, v1);
          const float ss = quad_sum(sumsq8(v0, v1));
          if (fq == 0) ssq2[(size_t)row * 32 + (u.pn * 2 + bj) * 4 + wc] = ss;
        }
      }
    }
  }
};


DI void phase_uc(const Params& p) {
  char* ws = p.ws;
  const bf16_t* U = (const bf16_t*)(ws + OFF_U);
  bf16_t* UC = (bf16_t*)(ws + OFF_UC);
  const int total = (MP / 8) * 128;
  for (int e = blockIdx.x * NTHR + threadIdx.x; e < total; e += gridDim.x * NTHR) {
    const int cc = e & 127, rb8 = e >> 7;
    const int ch0 = cc * 8, r0 = rb8 * 8;
    f32x4 w0[4], w1[4];
#pragma unroll
    for (int j = 0; j < 4; ++j) { w0[j] = ld4(p.b_conv_w + j * 1024 + ch0); w1[j] = ld4(p.b_conv_w + j * 1024 + ch0 + 4); }
    const f32x4 b0 = ld4(p.b_conv_b + ch0), b1 = ld4(p.b_conv_b + ch0 + 4);
    u32x4 ur[11];
#pragma unroll
    for (int q = 0; q < 11; ++q) { int rr = r0 - 3 + q; rr = rr < 0 ? 0 : rr; ur[q] = *(const u32x4*)(U + (size_t)rr * 1024 + ch0); }
#pragma unroll
    for (int t = 0; t < 8; ++t) {
      f32x4 o0 = b0, o1 = b1;
#pragma unroll
      for (int j = 0; j < 4; ++j) {
        const u32x4 u = ur[t + j];
        o0 += w0[j] * f32x4{bflo(u.x), bfhi(u.x), bflo(u.y), bfhi(u.y)};
        o1 += w1[j] * f32x4{bflo(u.z), bfhi(u.z), bflo(u.w), bfhi(u.w)};
      }
      *(u32x4*)(UC + (size_t)(r0 + t) * 1024 + ch0) = pack8(o0, o1);
    }
  }
}


template <int SH> DI float row_shr(float v, float ident) {
  return __builtin_bit_cast(float, __builtin_amdgcn_update_dpp(__builtin_bit_cast(int, ident), __builtin_bit_cast(int, v), 0x110 + SH, 0xf, 0xf, false));
}
struct EpiRG : EpiBase {
  DI void operator()(const f32x4 (&acc)[2][2][4][2], const pg8::Unit& u, int wr, int wc, int fr, int fq) const {
    const int ch0 = u.pn * 128 + wc * 32 + 8 * fq;
    float brg[8], big[8], spl8[8];
    { const f32x4 a0 = ld4(p.b_b_rg + ch0), a1 = ld4(p.b_b_rg + ch0 + 4), c0 = ld4(p.b_b_ig + ch0), c1 = ld4(p.b_b_ig + ch0 + 4), l0 = ld4(p.b_lam + ch0), l1 = ld4(p.b_lam + ch0 + 4);
#pragma unroll
      for (int e = 0; e < 4; ++e) { brg[e] = a0[e]; brg[4 + e] = a1[e]; big[e] = c0[e]; big[4 + e] = c1[e]; spl8[e] = l0[e]; spl8[4 + e] = l1[e]; }
#pragma unroll
      for (int e = 0; e < 8; ++e) { const float lam = spl8[e], z = __expf(-lam);
        const float sp = lam < -20.f ? -lam : (z < 1e-2f ? z * (1.f - z * (0.5f - z * (1.f / 3.f))) : __logf(1.f + z));
        spl8[e] = -8.f * sp; } }
    const bf16_t* UC = (const bf16_t*)(ws + OFF_UC);
    bf16_t* HSL = (bf16_t*)(ws + OFF_HSL); bf16_t* PC = (bf16_t*)(ws + OFF_PCUM);
#pragma unroll
    for (int ai = 0; ai < 2; ++ai) {
      const int row0 = u.pm * 256 + ai * 128 + wr * 64;
      const int chunk = row0 >> 6, b = chunk / NCH, pp0 = row0 - b * TP;
      float ch_[8], cP[8];
#pragma unroll
      for (int e = 0; e < 8; ++e) { ch_[e] = 0.f; cP[e] = 1.f; }
      u32x4 ucl[4];
#pragma unroll
      for (int m = 0; m < 4; ++m) ucl[m] = *(const u32x4*)(UC + (size_t)(row0 + m * 16 + fr) * 1024 + ch0);
#pragma unroll
      for (int m = 0; m < 4; ++m) {
        const int row = row0 + m * 16 + fr, pp = pp0 + m * 16 + fr;
        const u32x4 ucv = ucl[m];
        f32x4 hv[2], Pv[2];
#pragma unroll
        for (int n = 0; n < 2; ++n)
#pragma unroll
          for (int j = 0; j < 4; ++j) {
            const int e = 4 * n + j;
            const unsigned uw = (e >> 1) == 0 ? ucv.x : (e >> 1) == 1 ? ucv.y : (e >> 1) == 2 ? ucv.z : ucv.w;
            const float uc = (e & 1) ? bfhi(uw) : bflo(uw);
            const float r = sigmoid_f(acc[ai][0][m][n][j] + brg[e]);
            const float ig = sigmoid_f(acc[ai][1][m][n][j] + big[e]);
            float a = __expf(spl8[e] * r);
            float mult = __builtin_amdgcn_sqrtf(fmaxf(1.f - a * a, 0.f));
            if (pp == PAD) mult = 1.f;
            float bb = mult * ig * uc;
            if (pp < PAD) { a = 1.f; bb = 0.f; }
            { const float ap = row_shr<1>(a, 1.f), bp = row_shr<1>(bb, 0.f); bb = a * bp + bb; a = a * ap; }
            { const float ap = row_shr<2>(a, 1.f), bp = row_shr<2>(bb, 0.f); bb = a * bp + bb; a = a * ap; }
            { const float ap = row_shr<4>(a, 1.f), bp = row_shr<4>(bb, 0.f); bb = a * bp + bb; a = a * ap; }
            { const float ap = row_shr<8>(a, 1.f), bp = row_shr<8>(bb, 0.f); bb = a * bp + bb; a = a * ap; }
            const float h = bb + a * ch_[e], P = a * cP[e];
            ch_[e] = __shfl(h, 15, 16); cP[e] = __shfl(P, 15, 16);
            hv[n][j] = h; Pv[n][j] = P;
          }
        *(u32x4*)(HSL + (size_t)row * 1024 + ch0) = pack8(hv[0], hv[1]);
        *(u32x4*)(PC + (size_t)row * 1024 + ch0) = pack8(Pv[0], Pv[1]);
      }
      if (fr == 0) {
        float* ca = (float*)(ws + OFF_CARA) + (size_t)chunk * 1024 + ch0;
        float* cb = (float*)(ws + OFF_CARB) + (size_t)chunk * 1024 + ch0;
        *(f32x4*)ca = f32x4{cP[0], cP[1], cP[2], cP[3]}; *(f32x4*)(ca + 4) = f32x4{cP[4], cP[5], cP[6], cP[7]};
        *(f32x4*)cb = f32x4{ch_[0], ch_[1], ch_[2], ch_[3]}; *(f32x4*)(cb + 4) = f32x4{ch_[4], ch_[5], ch_[6], ch_[7]};
      }
    }
  }
};

template <class Epi>
DI void gemm8(const Params& p, char* smem, size_t offA, int lda, int M, size_t offB, int ldb, int N, int K, int a_pn_bytes = 0) {
  pg8::Gemm g; g.a_pn_bytes = a_pn_bytes; g.A = (const bf16_t*)(p.ws + offA); g.Bt = (const bf16_t*)(p.ws + offB); g.M = M; g.N = N; g.K = K; g.lda = lda; g.ldb = ldb;
  pg8::StaticOrder S; S.init(M, N, gridDim.x, blockIdx.x);
  Epi E; E.ws = p.ws; E.p = p;
  pg8::gemm_phase<Epi, pg8::StaticOrder, false>((PG8_LAS unsigned char*)smem, g, S, E, nullptr);
}


struct EpiQKV { EpiQ q; EpiK k; EpiV v;
  DI void operator()(const f32x4 (&acc)[2][2][4][2], const pg8::MUnit& u, int wr, int wc, int fr, int fq) const {
    const pg8::Unit uu{u.pm, u.pn};
    if (u.gid == 0) q(acc, uu, wr, wc, fr, fq); else if (u.gid == 1) k(acc, uu, wr, wc, fr, fq); else v(acc, uu, wr, wc, fr, fq);
  }
};
struct QKVTraits {
  static constexpr pg8::CDesc d[3] = {
    {OFF_QLAT, OFF_WUQ, 640, 384, 6, MP / 256, 6, 0, -1, 0, 0, -1},
    {OFF_QLAT + 768, OFF_WK, 640, 256, 4, MP / 256, 4, 0, -1, 0, 0, -1},
    {OFF_WV, OFF_QLAT + 768, 256, 640, 4, 4, MP / 256, 0, -1, 0, 0, -1}};
};
template <class T, class Epi> DI void run_stream(const Params& p, char* smem, const Epi& E) {
  pg8::MultiOrder<T> S; S.ws = p.ws; S.G = gridDim.x; S.c = blockIdx.x; S.ready = (unsigned*)(p.ws + OFF_RDY); S.tmo = (unsigned*)(p.ws + OFF_BAR) + XB_TMO;
  pg8::gemm_stream<Epi, pg8::MultiOrder<T>>((PG8_LAS unsigned char*)smem, S, E);
}
DI void phase_qkv_stream(const Params& p, char* smem) {
  EpiQKV E; E.q.ws = p.ws; E.q.p = p; E.k.ws = p.ws; E.k.p = p; E.v.ws = p.ws; E.v.p = p;
  run_stream<QKVTraits>(p, smem, E);
}

constexpr int N_PHASES = 12;

__global__ void __launch_bounds__(512, 2) fwd_mega(Params p, int ph_lo, int ph_hi, int coop) {
  __shared__ __attribute__((aligned(16))) char smem[SMEM_BYTES];
  XcdBarrier xb;
  if (coop) {
    if (threadIdx.x < 4) { ((volatile unsigned*)(smem + 2 * HALF_BYTES))[threadIdx.x] = 0u; }
    __syncthreads();
    xb = xcd_barrier_post((unsigned*)(p.ws + OFF_BAR), (volatile LAS unsigned*)(smem + 2 * HALF_BYTES));
    if (coop == 2) cg::this_grid().sync();
  }
#ifndef ONLY_PHASE
#define ONLY_PHASE -1
#endif
#ifndef DUP_MASK
#define DUP_MASK 0
#endif
#define RUN_PHASE(k, call) if ((ONLY_PHASE < 0 || ONLY_PHASE == (k)) && ph_lo <= (k) && (k) < ph_hi) { call; if ((DUP_MASK >> (k)) & 1) { if (coop) xcd_barrier(xb); call; } if (coop && (k) + 1 < ph_hi) xcd_barrier(xb); }
  RUN_PHASE(0, phase_prep(p, smem))
  RUN_PHASE(1, gemm8<EpiG1>(p, smem, OFF_XN0, 1024, MP, OFF_WINA, 1024, 1792, 1024))
  RUN_PHASE(2, phase_qkv_stream(p, smem))
  RUN_PHASE(3, phase_attn(p, smem))
  RUN_PHASE(4, gemm8<EpiOutA>(p, smem, OFF_Y, 1024, MP, OFF_WOUTA, 1024, 1024, 1024))
  RUN_PHASE(5, gemm8<EpiInB>(p, smem, OFF_H1B, 1024, MP, OFF_WINB, 1024, 2048, 1024))
  RUN_PHASE(6, phase_uc(p))
  RUN_PHASE(7, gemm8<EpiRG>(p, smem, OFF_UC, 1024, MP, OFF_WRG, 256, 2048, 256, 512))
  RUN_PHASE(8, phase_rg2(p))
  RUN_PHASE(9, phase_rg3(p))
  RUN_PHASE(10, gemm8<EpiOutB>(p, smem, OFF_HSL, 1024, MP, OFF_WOUTB, 1024, 1024, 1024))
  RUN_PHASE(11, phase_final(p))
}

extern "C" void kernel_launch(void* const* d_in, const int* in_sizes, int n_in, void* d_out, int out_size, void* d_ws,
                              size_t ws_size, hipStream_t stream) {
  static int grid_blocks = 0;
  if (!grid_blocks) {
    int dev = 0, cus = 0, per_cu = 0;
    (void)hipGetDevice(&dev);
    (void)hipDeviceGetAttribute(&cus, hipDeviceAttributeMultiprocessorCount, dev);
    (void)hipOccupancyMaxActiveBlocksPerMultiprocessor(&per_cu, fwd_mega, NTHR, 0);
    if (per_cu > 1) per_cu = 1;
    if (per_cu < 1) per_cu = 1;
    grid_blocks = cus * per_cu;
  }
  if (ws_size < WS_NEEDED) { fprintf(stderr, "workspace too small: %zu < %zu\n", ws_size, (size_t)WS_NEEDED); return; }
  Params p{};
  p.x = (const float*)d_in[0]; p.meta = (const float*)d_in[1];
  p.a_norm_g = (const float*)d_in[2]; p.a_w_in = (const float*)d_in[3]; p.a_q_norm_g = (const float*)d_in[4];
  p.a_kv_norm_g = (const float*)d_in[5]; p.a_w_uq = (const float*)d_in[6]; p.a_w_ukv = (const float*)d_in[7];
  p.a_w_out = (const float*)d_in[8]; p.b_norm_g = (const float*)d_in[9]; p.b_w_in = (const float*)d_in[10];
  p.b_conv_w = (const float*)d_in[11]; p.b_conv_b = (const float*)d_in[12]; p.b_w_rg = (const float*)d_in[13];
  p.b_b_rg = (const float*)d_in[14]; p.b_w_ig = (const float*)d_in[15]; p.b_b_ig = (const float*)d_in[16];
  p.b_lam = (const float*)d_in[17]; p.b_w_out = (const float*)d_in[18]; p.final_norm_g = (const float*)d_in[19];
  p.out = (float*)d_out; p.ws = (char*)d_ws;
#if SINGLE_LAUNCH
  (void)hipMemsetAsync((char*)d_ws + OFF_BAR, 0, 16384 + RDY_BYTES, stream);
  int lo = 0, hi = N_PHASES, coop = 1;
  void* args[] = {&p, &lo, &hi, &coop};
  hipError_t e = hipLaunchCooperativeKernel((void*)fwd_mega, dim3(grid_blocks), dim3(NTHR), args, 0, stream);
  if (e != hipSuccess) fprintf(stderr, "cooperative launch failed: %s (grid %d)\n", hipGetErrorString(e), grid_blocks);
#else
  for (int ph = 0; ph < N_PHASES; ++ph) fwd_mega<<<grid_blocks, NTHR, 0, stream>>>(p, ph, ph + 1, 0);
#endif
}
```
